# Optimizing an MI355X kernel written in HIP

```python
import jax
import jax.numpy as jnp
from jax import lax
import numpy as np

D_MODEL = 1024
BATCH = 2
SEQ = 8192
DEPTH = 2

GRID_W = 64
CTX_LEN = 256
N_MOD = 9
D_FF = 2816
N_BRANCH = 4
BRANCH_WIDTH = D_MODEL // 2
GLA_HEADS = 4
GLA_DV = BRANCH_WIDTH // GLA_HEADS
GLA_DK = GLA_DV // 2
GLA_RANK = 16
GLA_NORMALIZER = 16.0
GLA_CHUNK = 64
SGU_GROUPS = 4
SGU_GC = BRANCH_WIDTH // SGU_GROUPS
SGU_CHUNK = 128
FNET_GROUPS = 4
FNET_GC = BRANCH_WIDTH // FNET_GROUPS
CONV_TAPS = 3
EPS = 1e-6
IN_SIZES = (GLA_HEADS * GLA_DK, GLA_HEADS * GLA_DK, BRANCH_WIDTH, BRANCH_WIDTH, 2 * GLA_RANK,
            BRANCH_WIDTH, BRANCH_WIDTH, BRANCH_WIDTH, BRANCH_WIDTH, BRANCH_WIDTH, BRANCH_WIDTH)
COL_Q = GLA_HEADS * GLA_DK
COL_K = 2 * GLA_HEADS * GLA_DK
COL_V = COL_K + BRANCH_WIDTH
COL_R = COL_V + BRANCH_WIDTH
COL_A = COL_R + 2 * GLA_RANK
IN_WIDTH = COL_A + 6 * BRANCH_WIDTH

kernel_name = 'hybrid_gla_sgu_fnet_conv_dit_block'


def rmsnorm(x, g):
    x32 = x.astype(jnp.float32)
    y = x32 * lax.rsqrt(jnp.mean(x32 * x32, axis=-1, keepdims=True) + EPS)
    return (y * g.astype(jnp.float32)).astype(x.dtype)


def layernorm(x):
    x32 = x.astype(jnp.float32)
    xc = x32 - jnp.mean(x32, axis=-1, keepdims=True)
    var = jnp.mean(xc * xc, axis=-1, keepdims=True)
    return (xc * lax.rsqrt(var + EPS)).astype(x.dtype)


def adaln(cvec, w, b):
    m = jax.nn.silu(cvec) @ w + b
    return jnp.transpose(m.reshape(cvec.shape[0], N_MOD, D_MODEL), (1, 0, 2))[:, :, None, :]


def modulate(h, shift, scale):
    return h * (1.0 + scale) + shift


def swiglu(h, w1, w3, w2):
    return (jax.nn.silu(h @ w1) * (h @ w3)) @ w2


def ffn_half_step(s, g, mods, j, w1, w3, w2):
    h = modulate(rmsnorm(s, g), mods[j], mods[j + 1])
    return s + 0.5 * mods[j + 2] * swiglu(h, w1, w3, w2)


def split_columns(p, sizes):
    return jnp.split(p, np.cumsum(sizes)[:-1].tolist(), axis=-1)


def gla_scan(q, k, v, g, s0):
    bsz, L, H, _ = k.shape
    dv = v.shape[-1]
    n = L // GLA_CHUNK

    def chunks(t):
        return jnp.transpose(t.reshape(bsz, n, GLA_CHUNK, H, t.shape[-1]), (1, 0, 3, 2, 4))

    mask = jnp.tril(jnp.ones((GLA_CHUNK, GLA_CHUNK), dtype=bool))[:, :, None]
    xs = (chunks(k), chunks(v), chunks(g)) if q is None else (chunks(k), chunks(v), chunks(g), chunks(q))

    def step(s, inp):
        kc, vc, gc = (t.astype(jnp.float32) for t in inp[:3])
        b = jnp.cumsum(gc, axis=2)
        b_end = b[:, :, -1:, :]
        s_new = (jnp.exp(b_end)[:, :, 0, :, None] * s
                 + jnp.einsum('bhjd,bhje->bhde', kc * jnp.exp(b_end - b), vc))
        if q is None:
            return s_new, None
        qc = inp[3].astype(jnp.float32)
        o = jnp.einsum('bhid,bhde->bhie', qc * jnp.exp(b), s)
        decay = jnp.exp(jnp.where(mask, b[:, :, :, None, :] - b[:, :, None, :, :], -jnp.inf))
        a = jnp.einsum('bhid,bhjd,bhijd->bhij', qc, kc, decay)
        return s_new, o + jnp.einsum('bhij,bhje->bhie', a, vc)

    s_fin, o = lax.scan(step, s0, xs)
    if q is None:
        return None, s_fin
    o = jnp.transpose(o, (1, 0, 3, 2, 4)).reshape(bsz, L, H, dv).astype(v.dtype)
    return o, s_fin


def gla_mixer(q, k, v, r, a, w_a2, b_a2, g_o, s_f0, s_b0):
    bsz, L = k.shape[:2]
    kh = k.reshape(bsz, L, GLA_HEADS, GLA_DK)
    vh = v.reshape(bsz, L, GLA_HEADS, GLA_DV)

    def log_decay(a_dir, w, bias):
        logits = (a_dir @ w + bias).astype(jnp.float32)
        return (jax.nn.log_sigmoid(logits) / GLA_NORMALIZER).reshape(bsz, L, GLA_HEADS, GLA_DK)

    def flip(t):
        return jnp.flip(t, axis=1)

    g_f = log_decay(a[..., :GLA_RANK], w_a2[0], b_a2[0])
    g_b = log_decay(a[..., GLA_RANK:], w_a2[1], b_a2[1])
    if q is None:
        q_f, q_b = None, None
    else:
        qh = q.reshape(bsz, L, GLA_HEADS, GLA_DK) * (GLA_DK ** -0.5)
        q_f, q_b = qh, flip(qh)
    o_f, s_f = gla_scan(q_f, kh, vh, g_f, s_f0)
    o_b, s_b = gla_scan(q_b, flip(kh), flip(vh), flip(g_b), s_b0)
    if q is None:
        return None, s_f, s_b
    o = rmsnorm(o_f + flip(o_b), g_o) * jax.nn.silu(r.reshape(bsz, L, GLA_HEADS, GLA_DV))
    return o.reshape(bsz, L, BRANCH_WIDTH), s_f, s_b


def spatial_gating(u, v, w_s, b_s):
    bsz, L, _ = u.shape
    shape = (bsz, L // SGU_CHUNK, SGU_CHUNK, SGU_GROUPS, SGU_GC)
    z = layernorm(v.reshape(shape))
    s = jnp.einsum('gij,bnjgc->bnigc', w_s, z) + jnp.transpose(b_s)[None, None, :, :, None]
    return (u.reshape(shape) * s).reshape(bsz, L, BRANCH_WIDTH)


def fourier_mix(f):
    bsz, L, _ = f.shape
    f32 = f.astype(jnp.float32).reshape(bsz, L, FNET_GROUPS, FNET_GC)
    y = jnp.fft.fftn(f32, axes=(1, 3), norm='ortho').real
    return y.reshape(bsz, L, BRANCH_WIDTH).astype(f.dtype)


def conv3(z, w, axis):
    pad = [(0, 0)] * z.ndim
    pad[axis] = (1, 1)
    zp = jnp.pad(z, pad)
    n = z.shape[axis]
    tap = lambda s: lax.slice_in_dim(zp, s, s + n, axis=axis)
    return tap(0) * w[0] + tap(1) * w[1] + tap(2) * w[2]


def short_conv(cb, cc, cx, w, rows):
    z = cc * cx
    if rows is None:
        y = conv3(z, w, axis=1)
    else:
        bsz, L, ch = z.shape
        y = conv3(z.reshape(bsz, rows, GRID_W, ch), w, axis=2).reshape(bsz, L, ch)
    return cb * y


def mixer_branches(p, o_gla, w_sgu, b_sgu, w_conv, rows):
    su, sv, fn, cb, cc, cx = p[5:]
    return (o_gla, spatial_gating(su, sv, w_sgu, b_sgu), fourier_mix(fn),
            short_conv(cb, cc, cx, w_conv, rows))


def merge(h, branches, w_branch, w_gate, b_gate, w_out):
    m = None
    for k in range(N_BRANCH):
        term = jax.nn.sigmoid(h @ w_gate[k] + b_gate[k]) * (branches[k] @ w_branch[k])
        m = term if m is None else m + term
    return m @ w_out


def setup_inputs(seed: int = 0) -> dict:
    key = jax.random.key(seed)
    ks = jax.random.split(key, 22)

    def nrm(k, shape, scale):
        return scale * jax.random.normal(k, shape, jnp.float32)

    return {
        'x': nrm(ks[0], (BATCH, SEQ, D_MODEL), 1.0),
        'c': nrm(ks[1], (BATCH, D_MODEL), 1.0),
        'ctx': nrm(ks[2], (BATCH, CTX_LEN, D_MODEL), 1.0),
        'c_ctx': nrm(ks[3], (D_MODEL,), 1.0),
        'w_ada': nrm(ks[4], (DEPTH, D_MODEL, N_MOD * D_MODEL), 0.5 * D_MODEL ** -0.5),
        'b_ada': nrm(ks[5], (DEPTH, N_MOD * D_MODEL), 0.02),
        'g_norm': 1.0 + nrm(ks[6], (DEPTH, 3, D_MODEL), 0.05),
        'w_ff1': nrm(ks[7], (DEPTH, 2, D_MODEL, D_FF), D_MODEL ** -0.5),
        'w_ff3': nrm(ks[8], (DEPTH, 2, D_MODEL, D_FF), D_MODEL ** -0.5),
        'w_ff2': nrm(ks[9], (DEPTH, 2, D_FF, D_MODEL), D_FF ** -0.5),
        'w_in': nrm(ks[10], (DEPTH, D_MODEL, IN_WIDTH), D_MODEL ** -0.5),
        'w_gla_a2': nrm(ks[11], (DEPTH, 2, GLA_RANK, GLA_HEADS * GLA_DK), GLA_RANK ** -0.5),
        'b_gla_a2': 2.0 + nrm(ks[12], (DEPTH, 2, GLA_HEADS * GLA_DK), 0.1),
        'g_gla_norm': 1.0 + nrm(ks[13], (DEPTH, GLA_HEADS, GLA_DV), 0.05),
        'w_sgu': nrm(ks[14], (DEPTH, SGU_GROUPS, SGU_CHUNK, SGU_CHUNK), 0.5 * SGU_CHUNK ** -0.5),
        'b_sgu': 1.0 + nrm(ks[15], (DEPTH, SGU_GROUPS, SGU_CHUNK), 0.1),
        'w_conv': nrm(ks[16], (DEPTH, CONV_TAPS, BRANCH_WIDTH), CONV_TAPS ** -0.5),
        'w_branch': nrm(ks[17], (DEPTH, N_BRANCH, BRANCH_WIDTH, D_MODEL), BRANCH_WIDTH ** -0.5),
        'w_gate': nrm(ks[18], (DEPTH, N_BRANCH, D_MODEL, D_MODEL), D_MODEL ** -0.5),
        'b_gate': nrm(ks[19], (DEPTH, N_BRANCH, D_MODEL), 0.02),
        'w_out': nrm(ks[20], (DEPTH, D_MODEL, D_MODEL), D_MODEL ** -0.5),
        'g_final': 1.0 + nrm(ks[21], (D_MODEL,), 0.05),
    }


def reference(x, c, ctx, c_ctx, w_ada, b_ada, g_norm, w_ff1, w_ff3, w_ff2, w_in, w_gla_a2,
              b_gla_a2, g_gla_norm, w_sgu, b_sgu, w_conv, w_branch, w_gate, b_gate, w_out, g_final):
    rows = x.shape[1] // GRID_W
    s_zero = jnp.zeros((ctx.shape[0], GLA_HEADS, GLA_DK, GLA_DV), jnp.float32)
    for i in range(DEPTH):
        last = i == DEPTH - 1
        m_lat = adaln(c, w_ada[i], b_ada[i])
        m_ctx = adaln(c_ctx[None, :], w_ada[i], b_ada[i])
        gla_w = (w_gla_a2[i], b_gla_a2[i], g_gla_norm[i])

        x = ffn_half_step(x, g_norm[i, 0], m_lat, 0, w_ff1[i, 0], w_ff3[i, 0], w_ff2[i, 0])
        ctx = ffn_half_step(ctx, g_norm[i, 0], m_ctx, 0, w_ff1[i, 0], w_ff3[i, 0], w_ff2[i, 0])

        h_c = modulate(rmsnorm(ctx, g_norm[i, 1]), m_ctx[3], m_ctx[4])
        if last:
            wi = w_in[i]
            _, s_f, s_b = gla_mixer(None, h_c @ wi[:, COL_Q:COL_K], h_c @ wi[:, COL_K:COL_V], None,
                                    h_c @ wi[:, COL_R:COL_A], *gla_w, s_zero, s_zero)
        else:
            p_c = split_columns(h_c @ w_in[i], IN_SIZES)
            o_c, s_f, s_b = gla_mixer(*p_c[:5], *gla_w, s_zero, s_zero)

        h = modulate(rmsnorm(x, g_norm[i, 1]), m_lat[3], m_lat[4])
        p_l = split_columns(h @ w_in[i], IN_SIZES)
        o_l, _, _ = gla_mixer(*p_l[:5], *gla_w, s_f, s_b)
        y = merge(h, mixer_branches(p_l, o_l, w_sgu[i], b_sgu[i], w_conv[i], rows),
                  w_branch[i], w_gate[i], b_gate[i], w_out[i])
        x = x + m_lat[5] * y

        x = ffn_half_step(x, g_norm[i, 2], m_lat, 6, w_ff1[i, 1], w_ff3[i, 1], w_ff2[i, 1])

        if not last:
            y_c = merge(h_c, mixer_branches(p_c, o_c, w_sgu[i], b_sgu[i], w_conv[i], None),
                        w_branch[i], w_gate[i], b_gate[i], w_out[i])
            ctx = ctx + m_ctx[5] * y_c
            ctx = ffn_half_step(ctx, g_norm[i, 2], m_ctx, 6, w_ff1[i, 1], w_ff3[i, 1], w_ff2[i, 1])
    return rmsnorm(x, g_final)
```

```cpp
#include <hip/hip_runtime.h>
#include <hip/hip_cooperative_groups.h>
#include <cstdio>
namespace cg = cooperative_groups;

#define LAS __attribute__((address_space(3)))
typedef unsigned short bf16_t;
typedef short bf16x8 __attribute__((ext_vector_type(8)));
typedef float f32x4 __attribute__((ext_vector_type(4)));
typedef float f32x2 __attribute__((ext_vector_type(2)));
typedef unsigned u32x4 __attribute__((ext_vector_type(4)));
typedef unsigned u32x2 __attribute__((ext_vector_type(2)));

constexpr int ML = 16384, MT = 16896, DM = 1024, FF = 2816;
constexpr int LDPA = 2048, LDPB = 3072;
constexpr int LDS_BYTES = 147456;
constexpr float EPS = 1e-6f;

constexpr size_t SZ_W13 = (size_t)5632 * 1024 * 2, SZ_W2 = (size_t)1024 * 2816 * 2;
constexpr size_t WS_W13 = 0;
constexpr size_t WS_W2 = WS_W13 + 2 * SZ_W13;
constexpr size_t WS_WIN = WS_W2 + 2 * SZ_W2;
constexpr size_t WS_WG = WS_WIN + (size_t)5120 * 1024 * 2;
constexpr size_t WS_WB = WS_WG + (size_t)4096 * 1024 * 2;
constexpr size_t WS_WO = WS_WB + (size_t)5 * 1024 * 1024;
constexpr size_t WS_XC = WS_WO + (size_t)1024 * 1024 * 2;
constexpr size_t WS_H = WS_XC + (size_t)512 * 1024 * 4;
constexpr size_t WS_PA = WS_H + (size_t)MT * 1024 * 2;
constexpr size_t WS_PB = WS_PA + (size_t)MT * 2048 * 2;
constexpr size_t WS_FN = WS_PB + (size_t)MT * 3072 * 2;
constexpr size_t WS_S = WS_FN + (size_t)MT * 1024 * 2;
constexpr size_t WS_DT = WS_S + (size_t)16 * 132 * 8192 * 2;
constexpr size_t WS_MOD = WS_DT + (size_t)16 * 132 * 64 * 4;
constexpr size_t WS_TW = WS_MOD + (size_t)2 * 3 * 9216 * 4;
constexpr size_t WS_BAR = WS_TW + 65536;
constexpr size_t WS_GS = WS_BAR + 16384;
constexpr size_t WS_END = WS_GS + (size_t)MT * 1024 * 2;

struct Params {
    const float *x, *c, *ctx, *c_ctx, *w_ada, *b_ada, *g_norm, *w_ff1, *w_ff3, *w_ff2, *w_in, *w_gla_a2, *b_gla_a2, *g_gla_norm,
        *w_sgu, *b_sgu, *w_conv, *w_branch, *w_gate, *b_gate, *w_out, *g_final;
    float* out; unsigned char* ws;
};

typedef const __attribute__((address_space(4))) Params* KPtr;
__device__ __forceinline__ KPtr getkp() { KPtr q = (KPtr)__builtin_amdgcn_kernarg_segment_ptr(); asm volatile("" : "+s"(q)); return q; }
#define KP(f) (getkp()->f)
__device__ __forceinline__ int tid_() { int t = threadIdx.x; asm volatile("" : "+v"(t)); return t; }
__device__ __forceinline__ int bid_() { int b = blockIdx.x; asm volatile("" : "+s"(b)); return b; }
__device__ __forceinline__ unsigned f2bf(float f) { unsigned u = __float_as_uint(f); return (u + 0x7fffu + ((u >> 16) & 1u)) >> 16; }
__device__ __forceinline__ unsigned pk2(float lo, float hi) { return f2bf(lo) | (f2bf(hi) << 16); }
__device__ __forceinline__ float bflo(unsigned u) { return __uint_as_float(u << 16); }
__device__ __forceinline__ float bfhi(unsigned u) { return __uint_as_float(u & 0xffff0000u); }
__device__ __forceinline__ float bf2f(bf16_t b) { return __uint_as_float(((unsigned)b) << 16); }
__device__ __forceinline__ unsigned cvt_pk_bf16(float lo, float hi) { unsigned r; asm volatile("s_nop 1\n\tv_cvt_pk_bf16_f32 %0, %1, %2" : "=v"(r) : "v"(lo), "v"(hi)); return r; }
__device__ __forceinline__ float wave_sum(float v) {
#pragma unroll
    for (int o = 1; o < 64; o <<= 1) v += __shfl_xor(v, o);
    return v;
}
__device__ __forceinline__ float sigmoidf_(float x) { return __builtin_amdgcn_rcpf(1.f + __expf(-x)); }
__device__ __forceinline__ float siluf_(float x) { return x * sigmoidf_(x); }
__device__ __forceinline__ bf16x8 lfrag(const LAS bf16_t* base, int row, int ld, int k) { return *(const LAS bf16x8*)(base + row * ld + k); }

constexpr int HTB = 128 * 64 * 2;
__device__ __forceinline__ int lds_byte(int r, int c) { const int st = (r >> 4) * 2 + (c >> 5), rr = r & 15, cc = c & 31, ob = rr * 64 + cc * 2; return st * 1024 + (ob ^ (((ob >> 9) & 1) << 5)); }
__device__ __forceinline__ void stage_rc(int b, int& R, int& C) { const int st = b / 1024, sb = b % 1024, swz = sb ^ (((sb >> 9) & 1) << 5); R = (st >> 1) * 16 + swz / 64; C = (st & 1) * 32 + (swz % 64) / 2; }
__device__ __forceinline__ int perm32(int rho) { const int n = rho >> 4, i = rho & 15; return 8 * (i >> 2) + 4 * n + (i & 3); }

struct Unit { unsigned A, B, lda2, ldb2; int nt, pm, pn, kind; };

template <class Epi, class Sched>
__device__ __forceinline__ void gemm_phase(LAS unsigned char* lds, const unsigned char* wsb, const Sched& S, const Epi& E) {
    const int tid = tid_(), wid = __builtin_amdgcn_readfirstlane(tid >> 6), lane = tid & 63, wr = wid >> 2, wc = wid & 3, fr = lane & 15, fq = lane >> 4;
    unsigned Ra0, Rb0, Cc0;
    { int R, C; stage_rc(tid * 16, R, C); Ra0 = (unsigned)R; Rb0 = (unsigned)((R & ~31) + perm32(R & 31)); Cc0 = (unsigned)C * 2u; }
    const unsigned ldsw = (unsigned)wid * 1024u;
    const int aoff = lds_byte(wr * 64 + fr, fq * 8), boff = lds_byte(wc * 32 + fr, fq * 8);
#define G_SA(b, h) (((b) * 2 + (h)) * HTB)
#define G_SB(b, h) ((4 + (b) * 2 + (h)) * HTB)
#define G_STAGE_A(bufoff, uoff, ld) do { const unsigned _o = Ra0 * (ld) + (Cc0 + (uoff)); \
        __builtin_amdgcn_global_load_lds((const unsigned*)(wsb + (size_t)_o), (LAS unsigned*)(lds + (bufoff) + ldsw), 16, 0, 0); \
        __builtin_amdgcn_global_load_lds((const unsigned*)(wsb + (size_t)(_o + 64u * (ld))), (LAS unsigned*)(lds + (bufoff) + ldsw + 8192), 16, 0, 0); } while (0)
#define G_STAGE_B(bufoff, uoff, ld) do { const unsigned _o = Rb0 * (ld) + (Cc0 + (uoff)); \
        __builtin_amdgcn_global_load_lds((const unsigned*)(wsb + (size_t)_o), (LAS unsigned*)(lds + (bufoff) + ldsw), 16, 0, 0); \
        __builtin_amdgcn_global_load_lds((const unsigned*)(wsb + (size_t)(_o + 64u * (ld))), (LAS unsigned*)(lds + (bufoff) + ldsw + 8192), 16, 0, 0); } while (0)
#define G_LDA(dst, b, h) do { _Pragma("unroll") for (int m = 0; m < 4; ++m) _Pragma("unroll") for (int k = 0; k < 2; ++k) dst[m][k] = *(const LAS bf16x8*)(lds + G_SA(b, h) + aoff + m * 2048 + k * 1024); } while (0)
#define G_LDB(dst, b, h) do { _Pragma("unroll") for (int n = 0; n < 2; ++n) _Pragma("unroll") for (int k = 0; k < 2; ++k) dst[n][k] = *(const LAS bf16x8*)(lds + G_SB(b, h) + boff + n * 2048 + k * 1024); } while (0)
#define G_MMA(ai, bj, At, Bt) do { __builtin_amdgcn_s_setprio(1); _Pragma("unroll") for (int m = 0; m < 4; ++m) _Pragma("unroll") for (int n = 0; n < 2; ++n) _Pragma("unroll") for (int k = 0; k < 2; ++k) \
        acc[ai][bj][m][n] = __builtin_amdgcn_mfma_f32_16x16x32_bf16(Bt[n][k], At[m][k], acc[ai][bj][m][n], 0, 0, 0); __builtin_amdgcn_s_setprio(0); } while (0)
#define G_WAIT_V(n) asm volatile("s_waitcnt vmcnt(" #n ")" ::: "memory")
#define G_WAIT_L(n) asm volatile("s_waitcnt lgkmcnt(" #n ")" ::: "memory")
#define G_BAR __builtin_amdgcn_s_barrier()
#define G_SCHED __builtin_amdgcn_sched_barrier(0)
    Unit cur, nxt; int ui = 0;
    if (!S.next(0, cur)) return;
    f32x4 acc[2][2][4][2];
    bf16x8 At[4][2], B0[2][2], B1[2][2];
    {
        const unsigned cA = cur.A, cB = cur.B, la = cur.lda2, lb = cur.ldb2, hA = 128u * la, hB = 128u * lb;
        G_STAGE_B(G_SB(0, 0), cB, lb); G_STAGE_A(G_SA(0, 0), cA, la); G_STAGE_B(G_SB(0, 1), cB + hB, lb); G_STAGE_A(G_SA(0, 1), cA + hA, la);
        if (wr == 1) G_BAR;
        G_WAIT_V(4); G_BAR;
        G_STAGE_B(G_SB(1, 0), cB + 128u, lb); G_STAGE_A(G_SA(1, 0), cA + 128u, la); G_STAGE_B(G_SB(1, 1), cB + hB + 128u, lb);
        G_WAIT_V(6); G_BAR;
    }
    for (;;) {
#pragma unroll
        for (int a = 0; a < 2; ++a)
#pragma unroll
            for (int b = 0; b < 2; ++b)
#pragma unroll
                for (int m = 0; m < 4; ++m)
#pragma unroll
                    for (int n = 0; n < 2; ++n) acc[a][b][m][n] = (f32x4){0.f, 0.f, 0.f, 0.f};
        const bool has_next = S.next(ui + 1, nxt);
        if (!has_next) nxt = cur;
        const unsigned cA = cur.A, cB = cur.B, la = cur.lda2, lb = cur.ldb2;
        const int nt = cur.nt;
        for (int t = 0; t < nt; t += 2) {
            const bool last = (t == nt - 2);
            const unsigned a1 = cA + (unsigned)(t + 1) * 128u;
            const unsigned a2 = last ? nxt.A : cA + (unsigned)(t + 2) * 128u, b2 = last ? nxt.B : cB + (unsigned)(t + 2) * 128u;
            const unsigned la2 = last ? nxt.lda2 : la, lb2 = last ? nxt.ldb2 : lb;
            const unsigned a3 = a2 + 128u, b3 = b2 + 128u;
            G_LDB(B0, 0, 0); G_SCHED; G_LDA(At, 0, 0); G_STAGE_A(G_SA(1, 1), a1 + 128u * la, la);
            G_WAIT_L(8); G_BAR; G_WAIT_L(0); G_MMA(0, 0, At, B0); G_BAR; G_SCHED;
            G_LDB(B1, 0, 1); G_STAGE_B(G_SB(0, 0), b2, lb2);
            G_BAR; G_WAIT_L(0); G_MMA(0, 1, At, B1); G_BAR;
            G_LDA(At, 0, 1); G_STAGE_A(G_SA(0, 0), a2, la2);
            G_BAR; G_WAIT_L(0); G_MMA(1, 0, At, B0); G_BAR; G_SCHED;
            G_STAGE_B(G_SB(0, 1), b2 + 128u * lb2, lb2);
            G_WAIT_V(6); G_BAR; G_MMA(1, 1, At, B1); G_BAR;
            G_LDB(B0, 1, 0); G_SCHED; G_LDA(At, 1, 0); G_STAGE_A(G_SA(0, 1), a2 + 128u * la2, la2);
            G_WAIT_L(8); G_BAR; G_WAIT_L(0); G_MMA(0, 0, At, B0); G_BAR; G_SCHED;
            G_LDB(B1, 1, 1); G_STAGE_B(G_SB(1, 0), b3, lb2);
            G_BAR; G_WAIT_L(0); G_MMA(0, 1, At, B1); G_BAR;
            G_LDA(At, 1, 1); G_STAGE_A(G_SA(1, 0), a3, la2);
            G_BAR; G_WAIT_L(0); G_MMA(1, 0, At, B0); G_BAR; G_SCHED;
            G_STAGE_B(G_SB(1, 1), b3 + 128u * lb2, lb2);
            G_WAIT_V(6); G_BAR; G_MMA(1, 1, At, B1); G_BAR;
        }
        { int fr2 = fr, fq2 = fq; asm volatile("" : "+v"(fr2), "+v"(fq2));
          E(acc, cur, wr, wc, fr2, fq2); }
        if (!has_next) break;
        cur = nxt; ++ui;
    }
    G_WAIT_V(0);
    if (wr == 0) G_BAR;
    G_BAR;
#undef G_SA
#undef G_SB
#undef G_STAGE_A
#undef G_STAGE_B
#undef G_LDA
#undef G_LDB
#undef G_MMA
#undef G_WAIT_V
#undef G_WAIT_L
#undef G_BAR
#undef G_SCHED
}

struct SchedG {
    unsigned A, B, lda2, ldb2; int nt, nM, nN, nwg, G, c;
    __device__ __forceinline__ void init(size_t A_, unsigned lda2_, size_t B_, unsigned ldb2_, int K, int nM_, int nN_) {
        A = (unsigned)A_; B = (unsigned)B_; lda2 = lda2_; ldb2 = ldb2_; nt = K / 64; nM = nM_; nN = nN_; nwg = nM * nN; G = gridDim.x; c = bid_(); }
    __device__ __forceinline__ bool next(int i, Unit& u) const {
        const int L = i * G + c; if (L >= nwg) return false;
        int wgid = L; { const int q = nwg / 8, r = nwg % 8, xcd = wgid % 8, off = wgid / 8; wgid = (xcd < r ? xcd * (q + 1) : r * (q + 1) + (xcd - r) * q) + off; }
        const int nig = 8 * nN, gid = wgid / nig, fm = gid * 8, gsz = (nM - fm) < 8 ? (nM - fm) : 8;
        u.pm = fm + ((wgid % nig) % gsz); u.pn = (wgid % nig) / gsz;
        u.A = A + (unsigned)u.pm * 256u * lda2; u.B = B + (unsigned)u.pn * 256u * ldb2; u.lda2 = lda2; u.ldb2 = ldb2; u.nt = nt; u.kind = 0; return true;
    }
};
constexpr size_t WS_TBUF = WS_S;
constexpr size_t WS_GSC = WS_S + (size_t)4 * 1048576;
constexpr size_t WS_PART = WS_FN;
constexpr size_t WS_FT = WS_GS, WS_FTC = WS_GS + (size_t)2 * 256 * 8192 * 4, WS_FOS = WS_FTC + (size_t)2 * 256 * 256 * 4, WS_FOSC = WS_FOS + (size_t)2 * 256 * 8192 * 4;
struct SchedM {
    int nlat, nctx, G, c;
    __device__ __forceinline__ void fill(Unit& u, int pm, int pn, int k, int isb) const {
        u.pm = pm; u.pn = pn;
        if (!isb) { u.A = (unsigned)WS_H + (unsigned)pm * 256u * 2048u; u.lda2 = 2048; u.B = (unsigned)WS_WG + (unsigned)(k * 1024 + pn * 256) * 2048u; u.ldb2 = 2048; u.nt = 16; }
        else if (k == 2) { u.A = (unsigned)WS_FN + (unsigned)pm * 256u * 2048u; u.lda2 = 2048; u.B = (unsigned)WS_WB + 3u * 1048576u + (unsigned)pn * 256u * 2048u; u.ldb2 = 2048; u.nt = 16; }
        else { const unsigned colb = (k == 0) ? 4096u : (k == 1 ? 0u : 1024u); const unsigned wb = (k == 0) ? 0u : (k == 1 ? 1u : 2u);
            u.A = (unsigned)WS_PB + (unsigned)pm * 256u * 6144u + colb; u.lda2 = 6144; u.B = (unsigned)WS_WB + wb * 1048576u + (unsigned)pn * 256u * 1024u; u.ldb2 = 1024; u.nt = 8; }
    }
    __device__ __forceinline__ bool next(int i, Unit& u) const {
        const int nl = (c < nlat) ? (nlat - c + G - 1) / G : 0;
        const int vc = (G % 8 == 0) ? (c % 8) * (G / 8) + c / 8 : c;
        if (i < 8 * nl) { const int ti = i >> 3, sub = i & 7, id = ti * G + vc; u.kind = sub; fill(u, id >> 2, id & 3, sub >> 1, sub & 1); return true; }
        const int j = i - 8 * nl;
        if (c < nctx && j < 2) { const int t = c >> 2, k = c & 3; u.kind = 16 + 2 * k + j; fill(u, 64 + (t >> 2), t & 3, k, j); return true; }
        return false;
    }
};
struct SchedR {
    int op, f, nctx;
    __device__ __forceinline__ bool next(int i, Unit& u) const {
        const int L = i * (int)gridDim.x + (int)blockIdx.x;
        const unsigned A = op ? (unsigned)(WS_PB + 2048) : (unsigned)WS_PA, lda2 = op ? 6144u : 5632u;
        const unsigned B = op ? (unsigned)WS_WO : (unsigned)(WS_W2 + f * SZ_W2), ldb2 = op ? 2048u : 5632u;
        const bool islat = (L < 256);
        const int j = L - 256;
        if (!islat && j >= nctx) return false;
        const int xw = (L % 8) * 32 + (L / 8), gid = xw / 32;
        const int t = j >> 2, sp = j & 3;
        const int pm = islat ? gid * 8 + ((xw % 32) % 8) : 64 + (t >> 2);
        const int pn = islat ? (xw % 32) / 8 : (t & 3);
        const int k0 = (islat || op) ? 0 : 12 * sp - 2 * (sp >> 1) * (sp & 1);
        const int nt = op ? 16 : (islat ? 44 : 12 - 2 * (sp >> 1));
        const bool tb = (!islat && op);
        u.pm = pm; u.pn = pn; u.kind = islat ? 0 : sp; u.nt = nt; u.ldb2 = ldb2; u.lda2 = tb ? 2048u : lda2;
        u.A = tb ? (unsigned)WS_TBUF + (unsigned)sp * 1048576u + (unsigned)(pm - 64) * 256u * 2048u : A + (unsigned)pm * 256u * lda2 + (unsigned)k0 * 128u;
        u.B = B + (unsigned)pn * 256u * ldb2 + (unsigned)k0 * 128u;
        return true;
    }
};

struct EpiSwiGLU {
    unsigned char* ws;
    __device__ __forceinline__ void operator()(const f32x4 (&acc)[2][2][4][2], const Unit& u, int wr, int wc, int fr, int fq) const {
        bf16_t* U = (bf16_t*)(ws + WS_PA);
        const int row0 = u.pm * 256 + wr * 64 + fr, col0 = u.pn * 128 + wc * 32 + 8 * fq;
#pragma unroll
        for (int ai = 0; ai < 2; ++ai)
#pragma unroll
            for (int m = 0; m < 4; ++m) {
                const f32x4 a0 = acc[ai][0][m][0], a1 = acc[ai][0][m][1], b0 = acc[ai][1][m][0], b1 = acc[ai][1][m][1];
                u32x4 w;
                w.x = cvt_pk_bf16(siluf_(a0[0]) * b0[0], siluf_(a0[1]) * b0[1]); w.y = cvt_pk_bf16(siluf_(a0[2]) * b0[2], siluf_(a0[3]) * b0[3]);
                w.z = cvt_pk_bf16(siluf_(a1[0]) * b1[0], siluf_(a1[1]) * b1[1]); w.w = cvt_pk_bf16(siluf_(a1[2]) * b1[2], siluf_(a1[3]) * b1[3]);
                *(u32x4*)(U + (size_t)(row0 + ai * 128 + m * 16) * FF + col0) = w;
            }
    }
};
struct EpiResid {
    unsigned char* ws; int l, which, src_in; float coef;
    __device__ __forceinline__ void operator()(const f32x4 (&acc)[2][2][4][2], const Unit& u, int wr, int wc, int fr, int fq) const {
        const int row0 = u.pm * 256 + wr * 64 + fr, col0 = u.pn * 256 + wc * 32 + 8 * fq;
        const int mid = u.pm < 32 ? 0 : (u.pm < 64 ? 1 : 2);
        const float* gp = (const float*)(ws + WS_MOD) + (size_t)((l * 3 + mid) * 9 + which) * 1024 + col0;
        const bool isctx = (u.pm >= 64);
        float* dst = !isctx ? KP(out) + (size_t)row0 * 1024 : (float*)(ws + WS_PART) + (size_t)u.kind * 524288 + (size_t)(row0 - ML) * 1024;
        const float* src = dst;
        if (src_in && !isctx) src = KP(x) + (size_t)row0 * 1024;
        f32x4 gv[2][2];
#pragma unroll
        for (int bj = 0; bj < 2; ++bj)
#pragma unroll
            for (int n = 0; n < 2; ++n) gv[bj][n] = *(const f32x4*)(gp + bj * 128 + 4 * n) * coef;
#pragma unroll
        for (int aim = 0; aim < 2; ++aim) { const int ai = aim, m0 = 0;
            f32x4 rs[4][2][2];
#pragma unroll
            for (int m = m0; m < m0 + 4; ++m)
#pragma unroll
                for (int bj = 0; bj < 2; ++bj)
#pragma unroll
                    for (int n = 0; n < 2; ++n) { const size_t ro = (size_t)(ai * 128 + m * 16) * 1024; const int col = col0 + bj * 128 + 4 * n;
                        rs[m][bj][n] = isctx ? (f32x4){0.f, 0.f, 0.f, 0.f} : *(const f32x4*)(src + ro + col); }
#pragma unroll
            for (int m = m0; m < m0 + 4; ++m)
#pragma unroll
                for (int bj = 0; bj < 2; ++bj)
#pragma unroll
                    for (int n = 0; n < 2; ++n) { const size_t ro = (size_t)(ai * 128 + m * 16) * 1024; const int col = col0 + bj * 128 + 4 * n;
                        *(f32x4*)(dst + ro + col) = rs[m][bj][n] + gv[bj][n] * acc[ai][bj][m][n]; }
        }
    }
};
__device__ __forceinline__ float logdecay(float x) { return (fminf(x, 0.f) - __logf(1.f + __expf(-fabsf(x)))) * (1.f / 16.f); }
struct EpiInproj {
    unsigned char* ws; int l;
    __device__ __forceinline__ void operator()(const f32x4 (&acc)[2][2][4][2], const Unit& u, int wr, int wc, int fr, int fq) const {
        const int row0 = u.pm * 256 + wr * 64 + fr, cl0 = wc * 32 + 8 * fq;
        bf16_t* base; int ld;
        if (u.pn < 8) { base = (bf16_t*)(ws + WS_PA) + u.pn * 256; ld = LDPA; } else { base = (bf16_t*)(ws + WS_PB) + (u.pn - 8) * 256; ld = LDPB; }
        const bool dec = (u.pn == 6 || u.pn == 7);
        const float scl = (u.pn == 0) ? 0.125f : 1.f;
        f32x4 bv[2][2];
#pragma unroll
        for (int bj = 0; bj < 2; ++bj)
#pragma unroll
            for (int n = 0; n < 2; ++n) bv[bj][n] = (f32x4){0.f, 0.f, 0.f, 0.f};
        if (dec) { const float* b_a2 = KP(b_gla_a2) + (size_t)l * 512 + (u.pn - 6) * 256 + cl0;
#pragma unroll
            for (int bj = 0; bj < 2; ++bj)
#pragma unroll
                for (int n = 0; n < 2; ++n) bv[bj][n] = *(const f32x4*)(b_a2 + bj * 128 + 4 * n); }
#pragma unroll
        for (int ai = 0; ai < 2; ++ai)
#pragma unroll
            for (int m = 0; m < 4; ++m) {
                bf16_t* rowp = base + (size_t)(row0 + ai * 128 + m * 16) * ld + cl0;
#pragma unroll
                for (int bj = 0; bj < 2; ++bj) {
                    f32x4 v0 = acc[ai][bj][m][0], v1 = acc[ai][bj][m][1];
                    if (dec) {
                        v0 = v0 + bv[bj][0]; v1 = v1 + bv[bj][1];
#pragma unroll
                        for (int j = 0; j < 4; ++j) { v0[j] = logdecay(v0[j]); v1[j] = logdecay(v1[j]); }
                    } else { v0 = v0 * scl; v1 = v1 * scl; }
                    u32x4 w; w.x = cvt_pk_bf16(v0[0], v0[1]); w.y = cvt_pk_bf16(v0[2], v0[3]); w.z = cvt_pk_bf16(v1[0], v1[1]); w.w = cvt_pk_bf16(v1[2], v1[3]);
                    if (u.pn == 14 || u.pn == 15) {
                        const int row = row0 + ai * 128 + m * 16; const int pair0 = (u.pn - 14) * 128 + bj * 64 + (cl0 >> 1);
                        unsigned* ft = (row < ML) ? (unsigned*)(ws + WS_FT) + ((size_t)((row >> 13) * 256 + pair0)) * 8192 + (row & 8191)
                                                  : (unsigned*)(ws + WS_FTC) + ((size_t)(((row - ML) >> 8) * 256 + pair0)) * 256 + ((row - ML) & 255);
                        const size_t ps = (row < ML) ? 8192 : 256;
                        ft[0] = w.x; ft[ps] = w.y; ft[2 * ps] = w.z; ft[3 * ps] = w.w;
                    } else *(u32x4*)(rowp + bj * 128) = w;
                }
            }
    }
};
struct EpiMerge {
    unsigned char* ws; int l;
    __device__ __forceinline__ void operator()(const f32x4 (&acc)[2][2][4][2], const Unit& u, int wr, int wc, int fr, int fq) const {
        const int row0 = u.pm * 256 + wr * 64 + fr, col0 = u.pn * 256 + wc * 32 + 8 * fq;
        const bool isctx = (u.kind >= 16);
        const int k = (u.kind & 15) >> 1;
        bf16_t* Gs = isctx ? (bf16_t*)(ws + WS_GSC) + (size_t)k * 524288 - (size_t)ML * 1024 : (bf16_t*)(ws + WS_GS);
        if (!(u.kind & 1)) {
            const float* b_gate = KP(b_gate) + (size_t)l * 4096 + k * 1024 + col0;
            f32x4 bv[2][2];
#pragma unroll
            for (int bj = 0; bj < 2; ++bj)
#pragma unroll
                for (int n = 0; n < 2; ++n) bv[bj][n] = *(const f32x4*)(b_gate + bj * 128 + 4 * n);
#pragma unroll
            for (int ai = 0; ai < 2; ++ai)
#pragma unroll
                for (int m = 0; m < 4; ++m) {
                    bf16_t* rowp = Gs + (size_t)(row0 + ai * 128 + m * 16) * 1024 + col0;
#pragma unroll
                    for (int bj = 0; bj < 2; ++bj) {
                        const f32x4 v0 = acc[ai][bj][m][0] + bv[bj][0], v1 = acc[ai][bj][m][1] + bv[bj][1];
                        u32x4 w; w.x = cvt_pk_bf16(sigmoidf_(v0[0]), sigmoidf_(v0[1])); w.y = cvt_pk_bf16(sigmoidf_(v0[2]), sigmoidf_(v0[3]));
                        w.z = cvt_pk_bf16(sigmoidf_(v1[0]), sigmoidf_(v1[1])); w.w = cvt_pk_bf16(sigmoidf_(v1[2]), sigmoidf_(v1[3]));
                        *(u32x4*)(rowp + bj * 128) = w;
                    }
                }
        } else {
            bf16_t* Macc = (bf16_t*)(ws + WS_PA); bf16_t* Mb = (bf16_t*)(ws + WS_PB) + 1024;
#pragma unroll
            for (int aim = 0; aim < 4; ++aim) { const int ai = aim >> 1, m0 = (aim & 1) * 2;
                u32x4 gg[4][2]; u32x4 mq[4][2];
#pragma unroll
                for (int m = m0; m < m0 + 2; ++m)
#pragma unroll
                    for (int bj = 0; bj < 2; ++bj) {
                        const size_t row = (size_t)(row0 + ai * 128 + m * 16); const int col = col0 + bj * 128;
                        gg[m][bj] = __builtin_nontemporal_load((const u32x4*)(Gs + row * 1024 + col));
                        if (!isctx && k > 0) mq[m][bj] = __builtin_nontemporal_load((const u32x4*)(Macc + row * 1024 + col));
                        else mq[m][bj] = (u32x4){0u, 0u, 0u, 0u};
                    }
#pragma unroll
                for (int m = m0; m < m0 + 2; ++m) {
                    const size_t row = (size_t)(row0 + ai * 128 + m * 16);
#pragma unroll
                    for (int bj = 0; bj < 2; ++bj) {
                        const int col = col0 + bj * 128;
                        const u32x4 g = gg[m][bj];
                        f32x4 t0 = acc[ai][bj][m][0], t1 = acc[ai][bj][m][1];
                        t0[0] *= bflo(g.x); t0[1] *= bfhi(g.x); t0[2] *= bflo(g.y); t0[3] *= bfhi(g.y);
                        t1[0] *= bflo(g.z); t1[1] *= bfhi(g.z); t1[2] *= bflo(g.w); t1[3] *= bfhi(g.w);
                        if (isctx) { u32x4 w; w.x = cvt_pk_bf16(t0[0], t0[1]); w.y = cvt_pk_bf16(t0[2], t0[3]); w.z = cvt_pk_bf16(t1[0], t1[1]); w.w = cvt_pk_bf16(t1[2], t1[3]);
                            *(u32x4*)((bf16_t*)(ws + WS_TBUF) + (size_t)k * 524288 + (row - ML) * 1024 + col) = w; continue; }
                        bf16_t* mp = Macc + row * 1024 + col;
                        { const u32x4 q = mq[m][bj];
                          t0[0] += bflo(q.x); t0[1] += bfhi(q.x); t0[2] += bflo(q.y); t0[3] += bfhi(q.y); t1[0] += bflo(q.z); t1[1] += bfhi(q.z); t1[2] += bflo(q.w); t1[3] += bfhi(q.w); }
                        if (k < 3) { u32x4 w; w.x = cvt_pk_bf16(t0[0], t0[1]); w.y = cvt_pk_bf16(t0[2], t0[3]); w.z = cvt_pk_bf16(t1[0], t1[1]); w.w = cvt_pk_bf16(t1[2], t1[3]); *(u32x4*)mp = w; }
                        else { u32x4 w; w.x = cvt_pk_bf16(t0[0], t0[1]); w.y = cvt_pk_bf16(t0[2], t0[3]); w.z = cvt_pk_bf16(t1[0], t1[1]); w.w = cvt_pk_bf16(t1[2], t1[3]);
                            *(u32x4*)(Mb + row * LDPB + col) = w; }
                    }
                }
            }
        }
    }
};

__device__ __forceinline__ void conv_item(const float* W, int ldw, int src_col0, bf16_t* WT, int ldt, int dst_row0, int k0, LAS float* scr, int lane) {
    {
        const int r8 = lane >> 3, c4 = (lane & 7) * 4;
        f32x4 t[8];
#pragma unroll
        for (int i = 0; i < 8; ++i) t[i] = __builtin_nontemporal_load((const f32x4*)(W + (size_t)(k0 + 8 * i + r8) * ldw + src_col0 + c4));
#pragma unroll
        for (int i = 0; i < 8; ++i) { LAS float* d = scr + (8 * i + r8) * 33 + c4; d[0] = t[i][0]; d[1] = t[i][1]; d[2] = t[i][2]; d[3] = t[i][3]; }
    }
    asm volatile("s_waitcnt lgkmcnt(0)" ::: "memory");
    const int c = lane & 7;
#pragma unroll
    for (int j = 0; j < 4; ++j) { const int n = (lane >> 3) + 8 * j; const LAS float* s = scr + (8 * c) * 33 + n;
        u32x4 o; o.x = pk2(s[0 * 33], s[1 * 33]); o.y = pk2(s[2 * 33], s[3 * 33]); o.z = pk2(s[4 * 33], s[5 * 33]); o.w = pk2(s[6 * 33], s[7 * 33]);
        *(u32x4*)(WT + (size_t)(dst_row0 + n) * ldt + k0 + 8 * c) = o; }
    asm volatile("s_waitcnt lgkmcnt(0)" ::: "memory");
}

__device__ __forceinline__ void convert_layer(int l, LAS unsigned char* lds) {
    const int tid = tid_(), lane = tid & 63, wave = tid >> 6;
    LAS float* scr = (LAS float*)(lds + wave * 16384);
    unsigned char* ws = KP(ws);
    const int gw = bid_() * 8 + wave, NGW = gridDim.x * 8;
    constexpr int I_FF = 16 * 88, I_F2 = 44 * 32, I_INA = 16 * 48, I_INB = 16 * 96, I_G = 16 * 32, I_B = 8 * 32, I_O = 16 * 32;
    constexpr int NIT = 4 * I_FF + 2 * I_F2 + I_INA + I_INB + 4 * I_G + 3 * I_B + I_O;
    for (int it = gw; it < NIT; it += NGW) {
        int r = it;
        if (r < 4 * I_FF) {
            const int which = r / I_FF; r -= which * I_FF; const int f = which & 1, is3 = which >> 1;
            const int kb = r / 88, nb = r % 88, sc0 = nb * 32;
            const float* W = (is3 ? KP(w_ff3) : KP(w_ff1)) + ((size_t)(l * 2 + f)) * 1024 * 2816;
            bf16_t* WT = (bf16_t*)(ws + WS_W13 + f * SZ_W13);
            conv_item(W, 2816, sc0, WT, 1024, 256 * (sc0 / 128) + is3 * 128 + (sc0 % 128), kb * 64, scr, lane); continue; }
        r -= 4 * I_FF;
        if (r < 2 * I_F2) { const int f = r / I_F2; r -= f * I_F2; const int kb = r / 32, nb = r % 32;
            const float* W = KP(w_ff2) + ((size_t)(l * 2 + f)) * 2816 * 1024;
            conv_item(W, 1024, nb * 32, (bf16_t*)(ws + WS_W2 + f * SZ_W2), 2816, nb * 32, kb * 64, scr, lane); continue; }
        r -= 2 * I_F2;
        if (r < I_INA) { const int kb = r / 48, nb = r % 48;
            conv_item(KP(w_in) + (size_t)l * 1024 * 4640, 4640, nb * 32, (bf16_t*)(ws + WS_WIN), 1024, nb * 32, kb * 64, scr, lane); continue; }
        r -= I_INA;
        if (r < I_INB) { const int kb = r / 96, nb = r % 96; const int blk = nb / 16, within = (nb % 16) * 32;
            const int dstb = (blk == 0) ? 0 : (blk == 1) ? 1024 : (blk == 2) ? 1536 : (blk == 3) ? 512 : (blk == 4) ? 2048 : 2560;
            conv_item(KP(w_in) + (size_t)l * 1024 * 4640, 4640, 1568 + blk * 512 + within, (bf16_t*)(ws + WS_WIN), 1024, 2048 + dstb + within, kb * 64, scr, lane); continue; }
        r -= I_INB;
        if (r < 4 * I_G) { const int k = r / I_G; r -= k * I_G; const int kb = r / 32, nb = r % 32;
            conv_item(KP(w_gate) + ((size_t)(l * 4 + k)) * 1024 * 1024, 1024, nb * 32, (bf16_t*)(ws + WS_WG), 1024, k * 1024 + nb * 32, kb * 64, scr, lane); continue; }
        r -= 4 * I_G;
        if (r < 3 * I_B) { const int wb = r / I_B; r -= wb * I_B; const int kb = r / 32, nb = r % 32; const int k = (wb == 2) ? 3 : wb;
            conv_item(KP(w_branch) + ((size_t)(l * 4 + k)) * 512 * 1024, 1024, nb * 32, (bf16_t*)(ws + WS_WB + (size_t)wb * 1048576), 512, nb * 32, kb * 64, scr, lane); continue; }
        r -= 3 * I_B;
        { const int kb = r / 32, nb = r % 32;
            conv_item(KP(w_out) + (size_t)l * 1024 * 1024, 1024, nb * 32, (bf16_t*)(ws + WS_WO), 1024, nb * 32, kb * 64, scr, lane); }
    }
    __syncthreads();
    LAS float* ctab = (LAS float*)lds; LAS float* stab = ctab + 128;
    if (tid < 128) { float s, c; sincospif((float)tid * (1.f / 64.f), &s, &c); ctab[tid] = c; stab[tid] = s; }
    __syncthreads();
    const size_t gt = (size_t)bid_() * 512 + tid, NT = (size_t)gridDim.x * 512;
    {
        const float* win = KP(w_in) + (size_t)l * 1024 * 4640; const float* wa2 = KP(w_gla_a2) + (size_t)l * 2 * 16 * 256; bf16_t* WIN = (bf16_t*)(ws + WS_WIN);
        for (size_t idx = gt; idx < (size_t)2 * 256 * 1024; idx += NT) {
            const int dir = (int)(idx >> 18), n = (int)(idx >> 10) & 255, k = (int)idx & 1023;
            const f32x4* a = (const f32x4*)(win + (size_t)k * 4640 + 1536 + dir * 16);
            const float* w = wa2 + (size_t)dir * 16 * 256 + n;
            float s = 0.f;
#pragma unroll
            for (int q = 0; q < 4; ++q) { const f32x4 av = a[q]; s += av[0] * w[(4 * q + 0) * 256] + av[1] * w[(4 * q + 1) * 256] + av[2] * w[(4 * q + 2) * 256] + av[3] * w[(4 * q + 3) * 256]; }
            WIN[(size_t)(1536 + dir * 256 + n) * 1024 + k] = (bf16_t)f2bf(s);
        }
    }
    {
        const float* wb = KP(w_branch) + ((size_t)(l * 4 + 2)) * 512 * 1024; bf16_t* WB2 = (bf16_t*)(ws + WS_WB + (size_t)3 * 1048576);
        const float s128 = 0.08838834764831845f;
        for (size_t idx = gt; idx < (size_t)65536; idx += NT) {
            const int n = (int)idx & 1023, g = (int)(idx >> 10) & 3, q = (int)(idx >> 12);
            const float* col = wb + (size_t)(g * 128) * 1024 + n;
            float ac[8], as[8];
#pragma unroll
            for (int r = 0; r < 8; ++r) { ac[r] = 0.f; as[r] = 0.f; }
#pragma unroll 8
            for (int k2 = 0; k2 < 128; ++k2) { const float w = col[(size_t)k2 * 1024];
#pragma unroll
                for (int r = 0; r < 8; ++r) { const int m = (k2 * (8 * q + r)) & 127; ac[r] += ctab[m] * w; as[r] += stab[m] * w; } }
            u32x4 oc, os;
            oc.x = pk2(ac[0] * s128, ac[1] * s128); oc.y = pk2(ac[2] * s128, ac[3] * s128); oc.z = pk2(ac[4] * s128, ac[5] * s128); oc.w = pk2(ac[6] * s128, ac[7] * s128);
            os.x = pk2(-as[0] * s128, -as[1] * s128); os.y = pk2(-as[2] * s128, -as[3] * s128); os.z = pk2(-as[4] * s128, -as[5] * s128); os.w = pk2(-as[6] * s128, -as[7] * s128);
            bf16_t* o = WB2 + (size_t)n * 1024 + g * 128 + 8 * q;
            *(u32x4*)o = oc; *(u32x4*)(o + 512) = os;
        }
    }
    __syncthreads();
}

__device__ __forceinline__ void mods_phase(LAS unsigned char* lds) {
    const int tid = tid_(), lane = tid & 63, wave = tid >> 6;
    if (bid_() >= 72) return;
    LAS float* sc = (LAS float*)lds; LAS float* red = sc + 3072;
    for (int i = tid; i < 3072; i += 512) { const int v = i >> 10, k = i & 1023; const float x = (v < 2) ? KP(c)[v * 1024 + k] : KP(c_ctx)[k]; sc[i] = x / (1.f + __expf(-x)); }
    __syncthreads();
    for (int it = bid_(); it < 72; it += gridDim.x) {
        const int l = it / 36, cb = it % 36;
        const float* W = KP(w_ada) + (size_t)l * 1024 * 9216 + cb * 256 + 4 * lane;
        f32x4 a0 = {0.f, 0.f, 0.f, 0.f}, a1 = a0, a2 = a0;
#pragma unroll 8
        for (int i = 0; i < 128; ++i) { const int k = wave + 8 * i; const f32x4 w = *(const f32x4*)(W + (size_t)k * 9216);
            a0 = a0 + w * sc[k]; a1 = a1 + w * sc[1024 + k]; a2 = a2 + w * sc[2048 + k]; }
        *(LAS f32x4*)(red + (wave * 3 + 0) * 256 + 4 * lane) = a0; *(LAS f32x4*)(red + (wave * 3 + 1) * 256 + 4 * lane) = a1; *(LAS f32x4*)(red + (wave * 3 + 2) * 256 + 4 * lane) = a2;
        __syncthreads();
        float* MOD = (float*)(KP(ws) + WS_MOD);
        for (int o = tid; o < 768; o += 512) { const int v = o >> 8, cc = o & 255; float s = KP(b_ada)[(size_t)l * 9216 + cb * 256 + cc];
#pragma unroll
            for (int w = 0; w < 8; ++w) s += red[(w * 3 + v) * 256 + cc];
            MOD[(size_t)(l * 3 + v) * 9216 + cb * 256 + cc] = s; }
        __syncthreads();
    }
}

__device__ __forceinline__ void norm_load_row(f32x4 (&v)[4], int row, const float* src_lat, const float* src_ctx, const float* parts, int nparts, int lane) {
    const float* xr = (row < ML) ? src_lat + (size_t)row * 1024 : src_ctx + (size_t)(row - ML) * 1024;
#pragma unroll
    for (int j = 0; j < 4; ++j) v[j] = *(const f32x4*)(xr + 4 * lane + 256 * j);
    if (row >= ML && nparts) {
#pragma unroll
        for (int s2 = 0; s2 < 4; ++s2)
#pragma unroll
            for (int j = 0; j < 4; ++j) v[j] = v[j] + *(const f32x4*)(parts + (size_t)s2 * 524288 + (size_t)(row - ML) * 1024 + 4 * lane + 256 * j);
    }
}
__device__ __forceinline__ void norm_finish_row(const f32x4 (&v)[4], int row, const float* g, const float* modl, int jshift, int jscale, bf16_t* H, float* xc, int lane) {
    const int mid = row < 8192 ? 0 : (row < ML ? 1 : 2);
    const float* sh = modl + (size_t)(mid * 9 + jshift) * 1024; const float* scp = modl + (size_t)(mid * 9 + jscale) * 1024;
    float ss = 0.f;
#pragma unroll
    for (int j = 0; j < 4; ++j) ss += v[j][0] * v[j][0] + v[j][1] * v[j][1] + v[j][2] * v[j][2] + v[j][3] * v[j][3];
    const float rinv = rsqrtf(wave_sum(ss) * (1.f / 1024.f) + EPS);
#pragma unroll
    for (int j = 0; j < 4; ++j) { const int col = 4 * lane + 256 * j;
        const f32x4 gv = *(const f32x4*)(g + col), shv = *(const f32x4*)(sh + col), scv = *(const f32x4*)(scp + col);
        f32x4 y = v[j] * rinv * gv; y = y * (scv + 1.f) + shv;
        u32x2 o; o.x = pk2(y[0], y[1]); o.y = pk2(y[2], y[3]);
        *(u32x2*)(H + (size_t)row * 1024 + col) = o;
        if (row >= ML) *(f32x4*)(xc + (size_t)(row - ML) * 1024 + col) = v[j]; }
}
__device__ __forceinline__ void norm_phase(const float* src_lat, const float* src_ctx, const float* g, const float* modl, int jshift, int jscale, bf16_t* H, int nrows, const float* parts, int nparts, float* xc) {
    const int lane = tid_() & 63, wave = tid_() >> 6;
    const int gw = bid_() * 8 + wave, NGW = gridDim.x * 8;
    for (int row = gw; row < nrows; row += 2 * NGW) {
        const int r1 = row + NGW; const bool has1 = r1 < nrows;
        f32x4 va[4], vb[4];
        norm_load_row(va, row, src_lat, src_ctx, parts, nparts, lane);
        if (has1) norm_load_row(vb, r1, src_lat, src_ctx, parts, nparts, lane);
        else {
#pragma unroll
            for (int j = 0; j < 4; ++j) vb[j] = (f32x4){0.f, 0.f, 0.f, 0.f}; }
        norm_finish_row(va, row, g, modl, jshift, jscale, H, xc, lane);
        if (has1) norm_finish_row(vb, r1, g, modl, jshift, jscale, H, xc, lane);
    }
}
__device__ __forceinline__ void final_norm(float* out, const float* g) {
    const int lane = tid_() & 63, wave = tid_() >> 6;
    const int gw = bid_() * 8 + wave, NGW = gridDim.x * 8;
    for (int row = gw; row < ML; row += 2 * NGW) {
        const int r1 = (row + NGW < ML) ? row + NGW : row;
        float* xa = out + (size_t)row * 1024; float* xb = out + (size_t)r1 * 1024;
        f32x4 va[4], vb[4]; float sa = 0.f, sb = 0.f;
#pragma unroll
        for (int j = 0; j < 4; ++j) { va[j] = *(const f32x4*)(xa + 4 * lane + 256 * j); vb[j] = *(const f32x4*)(xb + 4 * lane + 256 * j); }
#pragma unroll
        for (int j = 0; j < 4; ++j) { sa += va[j][0] * va[j][0] + va[j][1] * va[j][1] + va[j][2] * va[j][2] + va[j][3] * va[j][3]; sb += vb[j][0] * vb[j][0] + vb[j][1] * vb[j][1] + vb[j][2] * vb[j][2] + vb[j][3] * vb[j][3]; }
        const float ra = rsqrtf(wave_sum(sa) * (1.f / 1024.f) + EPS), rb = rsqrtf(wave_sum(sb) * (1.f / 1024.f) + EPS);
#pragma unroll
        for (int j = 0; j < 4; ++j) { const int col = 4 * lane + 256 * j; const f32x4 gv = *(const f32x4*)(g + col);
            *(f32x4*)(xa + col) = va[j] * ra * gv; if (r1 != row) *(f32x4*)(xb + col) = vb[j] * rb * gv; }
    }
}

__device__ __forceinline__ int chunk_row0(int b, int c) { return (c < 4) ? (ML + b * 256 + c * 64) : (b * 8192 + (c - 4) * 64); }

__device__ __forceinline__ void gla_cumsum(LAS float* gs, const bf16_t* PA, int row0, int h, int tid) {
    {
        bf16_t t[16];
#pragma unroll
        for (int u = 0; u < 16; ++u) { const int idx = tid + 512 * u; const int dir = idx >> 12, pp = (idx >> 6) & 63, d = idx & 63;
            t[u] = PA[(size_t)(row0 + pp) * LDPA + 1536 + dir * 256 + h * 64 + d]; }
#pragma unroll
        for (int u = 0; u < 16; ++u) gs[tid + 512 * u] = bf2f(t[u]);
    }
    __syncthreads();
    {
        const int col = tid & 127, seg = tid >> 7, dir = col >> 6, d = col & 63;
        LAS float* segsum = gs + 8192;
        LAS float* g0 = gs + dir * 4096 + d;
        float s = 0.f;
        if (dir == 0) { for (int q = 0; q < 16; ++q) { const int pp = 16 * seg + q; s += g0[pp * 64]; g0[pp * 64] = s; } }
        else { for (int q = 15; q >= 0; --q) { const int pp = 16 * seg + q; s += g0[pp * 64]; g0[pp * 64] = s; } }
        segsum[seg * 128 + col] = s;
        __syncthreads();
        float off = 0.f;
        if (dir == 0) { for (int t = 0; t < seg; ++t) off += segsum[t * 128 + col]; }
        else { for (int t = 3; t > seg; --t) off += segsum[t * 128 + col]; }
        for (int q = 0; q < 16; ++q) { const int pp = 16 * seg + q; g0[pp * 64] += off; }
    }
    __syncthreads();
}

__device__ __forceinline__ void gla1_item(LAS unsigned char* lds, int item) {
    const int tid = tid_(), lane = tid & 63, wave = tid >> 6;
    const int c = item % 132, h = (item / 132) & 3, b = item / 528;
    const int row0 = chunk_row0(b, c);
    const bf16_t* PA = (const bf16_t*)(KP(ws) + WS_PA);
    LAS float* gs = (LAS float*)lds;
    LAS bf16_t* kdec = (LAS bf16_t*)(lds + 32768);
    LAS bf16_t* vt = (LAS bf16_t*)(lds + 32768 + 18432);
    gla_cumsum(gs, PA, row0, h, tid);
    {
        bf16_t tk[16], tv[16];
#pragma unroll
        for (int u = 0; u < 16; ++u) { const int idx = tid + 512 * u; const int pp = (idx >> 6) & 63, d = idx & 63;
            tk[u] = PA[(size_t)(row0 + pp) * LDPA + 256 + h * 64 + d];
            tv[u] = PA[(size_t)(row0 + (idx >> 7)) * LDPA + 512 + h * 128 + (idx & 127)]; }
#pragma unroll
        for (int u = 0; u < 16; ++u) { const int idx = tid + 512 * u; const int dir = idx >> 12, pp = (idx >> 6) & 63, d = idx & 63;
            const float be = dir ? gs[4096 + d] : gs[63 * 64 + d];
            kdec[(dir * 64 + d) * 72 + pp] = (bf16_t)f2bf(bf2f(tk[u]) * __expf(be - gs[idx]));
            vt[(idx & 127) * 72 + (idx >> 7)] = tv[u]; }
    }
    if (tid < 128) { const int dir = tid >> 6, d = tid & 63; const float be = dir ? gs[4096 + d] : gs[63 * 64 + d];
        ((float*)(KP(ws) + WS_DT))[((size_t)((dir * 8 + b * 4 + h) * 132 + c)) * 64 + d] = __expf(be); }
    __syncthreads();
    {
        const int dir = wave >> 2, mt = wave & 3;
        bf16_t* slot = (bf16_t*)(KP(ws) + WS_S) + ((size_t)((dir * 8 + b * 4 + h) * 132 + c)) * 8192;
        const LAS bf16_t* ka = kdec + dir * 64 * 72;
#pragma unroll
        for (int nt = 0; nt < 8; ++nt) {
            f32x4 acc = {0.f, 0.f, 0.f, 0.f};
#pragma unroll
            for (int ks = 0; ks < 2; ++ks) {
                const bf16x8 a = lfrag(ka, mt * 16 + (lane & 15), 72, ks * 32 + (lane >> 4) * 8);
                const bf16x8 bb = lfrag(vt, nt * 16 + (lane & 15), 72, ks * 32 + (lane >> 4) * 8);
                acc = __builtin_amdgcn_mfma_f32_16x16x32_bf16(a, bb, acc, 0, 0, 0);
            }
            const int dk0 = mt * 16 + (lane >> 4) * 4, dv = nt * 16 + (lane & 15);
            u32x2 o; o.x = pk2(acc[0], acc[1]); o.y = pk2(acc[2], acc[3]);
            *(u32x2*)(slot + dv * 64 + dk0) = o;
        }
    }
    __syncthreads();
}

__device__ __forceinline__ void gla_scan() {
    unsigned* S32 = (unsigned*)(KP(ws) + WS_S); const float* DT = (const float*)(KP(ws) + WS_DT);
    const int gt = bid_() * 512 + tid_(), NT = gridDim.x * 512;
    for (int w = gt; w < 65536; w += NT) {
        const int chain = w >> 12, e2 = w & 4095, dir = chain >> 3;
        const int dk = (2 * e2) & 63;
        float s0 = 0.f, s1 = 0.f;
        for (int st = 0; st < 132; st += 12) {
            unsigned kd[12]; f32x2 dd[12]; size_t off[12];
#pragma unroll
            for (int q = 0; q < 12; ++q) { const int stq = st + q; const int c = dir ? (stq < 4 ? 3 - stq : 135 - stq) : stq;
                off[q] = ((size_t)(chain * 132 + c)) * 4096 + e2; kd[q] = S32[off[q]]; dd[q] = *(const f32x2*)(DT + ((size_t)(chain * 132 + c)) * 64 + dk); }
#pragma unroll
            for (int q = 0; q < 12; ++q) { S32[off[q]] = pk2(s0, s1); s0 = dd[q][0] * s0 + bflo(kd[q]); s1 = dd[q][1] * s1 + bfhi(kd[q]); }
        }
    }
}

__device__ __forceinline__ void gla3_item(int l, LAS unsigned char* lds, int item) {
    const int tid = tid_(), lane = tid & 63, wave = tid >> 6;
    const int c = item % 132, h = (item / 132) & 3, b = item / 528;
    const int row0 = chunk_row0(b, c);
    const bf16_t* PA = (const bf16_t*)(KP(ws) + WS_PA); bf16_t* PB = (bf16_t*)(KP(ws) + WS_PB);
    LAS float* gs = (LAS float*)lds;
    LAS bf16_t* af = (LAS bf16_t*)lds;
    LAS bf16_t* qd = (LAS bf16_t*)(lds + 32768);
    LAS bf16_t* kd = (LAS bf16_t*)(lds + 51200);
    LAS bf16_t* Sd = (LAS bf16_t*)(lds + 69632);
    LAS bf16_t* vt = (LAS bf16_t*)(lds + 106496);
    LAS float* ssq = (LAS float*)(lds + 124928);
    gla_cumsum(gs, PA, row0, h, tid);
    {
        bf16_t tq[8], tk[8], tv[16]; u32x4 ts[4];
#pragma unroll
        for (int u = 0; u < 8; ++u) { const int idx = tid + 512 * u; const int pp = idx >> 6, d = idx & 63;
            tq[u] = PA[(size_t)(row0 + pp) * LDPA + h * 64 + d]; tk[u] = PA[(size_t)(row0 + pp) * LDPA + 256 + h * 64 + d]; }
#pragma unroll
        for (int u = 0; u < 16; ++u) { const int idx = tid + 512 * u; tv[u] = PA[(size_t)(row0 + (idx >> 7)) * LDPA + 512 + h * 128 + (idx & 127)]; }
#pragma unroll
        for (int u = 0; u < 4; ++u) { const int idx = tid + 512 * u; const int dir = idx >> 10, dv = (idx >> 3) & 127, part = idx & 7;
            const bf16_t* slot = (const bf16_t*)(KP(ws) + WS_S) + ((size_t)((dir * 8 + b * 4 + h) * 132 + c)) * 8192;
            ts[u] = *(const u32x4*)(slot + dv * 64 + part * 8); }
#pragma unroll
        for (int u = 0; u < 8; ++u) { const int idx = tid + 512 * u; const int pp = idx >> 6, d = idx & 63;
            const float q = bf2f(tq[u]), k = bf2f(tk[u]);
            const float bf = gs[idx], bb = gs[4096 + idx];
            qd[pp * 72 + d] = (bf16_t)f2bf(q * __expf(bf)); kd[pp * 72 + d] = (bf16_t)f2bf(k * __expf(-bf));
            qd[(64 + pp) * 72 + d] = (bf16_t)f2bf(q * __expf(bb)); kd[(64 + pp) * 72 + d] = (bf16_t)f2bf(k * __expf(-bb)); }
#pragma unroll
        for (int u = 0; u < 16; ++u) { const int idx = tid + 512 * u; vt[(idx & 127) * 72 + (idx >> 7)] = tv[u]; }
#pragma unroll
        for (int u = 0; u < 4; ++u) { const int idx = tid + 512 * u; const int dir = idx >> 10, dv = (idx >> 3) & 127, part = idx & 7;
            *(LAS u32x4*)(Sd + (dir * 128 + dv) * 72 + part * 8) = ts[u]; }
    }
    __syncthreads();
    {
        const int dir = wave >> 2, mt = wave & 3; const int i = mt * 16 + (lane & 15);
#pragma unroll
        for (int nt = 0; nt < 4; ++nt) {
            f32x4 acc = {0.f, 0.f, 0.f, 0.f};
#pragma unroll
            for (int ks = 0; ks < 2; ++ks) {
                const bf16x8 kf = lfrag(kd + dir * 64 * 72, nt * 16 + (lane & 15), 72, ks * 32 + (lane >> 4) * 8);
                const bf16x8 qf = lfrag(qd + dir * 64 * 72, i, 72, ks * 32 + (lane >> 4) * 8);
                acc = __builtin_amdgcn_mfma_f32_16x16x32_bf16(kf, qf, acc, 0, 0, 0);
            }
            const int j0 = nt * 16 + (lane >> 4) * 4;
#pragma unroll
            for (int jj = 0; jj < 4; ++jj) { const int j = j0 + jj; const bool keep = dir ? (j >= i) : (j <= i); acc[jj] = keep ? acc[jj] : 0.f; }
            u32x2 o; o.x = pk2(acc[0], acc[1]); o.y = pk2(acc[2], acc[3]);
            *(LAS u32x2*)(af + (dir * 64 + i) * 72 + j0) = o;
        }
    }
    __syncthreads();
    {
        const int mt = wave >> 1, nt0 = 4 * (wave & 1); const int i = mt * 16 + (lane & 15);
        f32x4 acc[4];
#pragma unroll
        for (int nt = 0; nt < 4; ++nt) acc[nt] = (f32x4){0.f, 0.f, 0.f, 0.f};
#pragma unroll
        for (int seg = 0; seg < 4; ++seg) {
            const int dir = seg >> 1;
            const LAS bf16_t* Aop = (seg & 1) ? (af + dir * 64 * 72) : (qd + dir * 64 * 72);
            const LAS bf16_t* Bop = (seg & 1) ? vt : (Sd + dir * 128 * 72);
#pragma unroll
            for (int ks = 0; ks < 2; ++ks) {
                const bf16x8 a = lfrag(Aop, i, 72, ks * 32 + (lane >> 4) * 8);
#pragma unroll
                for (int nt = 0; nt < 4; ++nt) {
                    const bf16x8 bb = lfrag(Bop, (nt0 + nt) * 16 + (lane & 15), 72, ks * 32 + (lane >> 4) * 8);
                    acc[nt] = __builtin_amdgcn_mfma_f32_16x16x32_bf16(bb, a, acc[nt], 0, 0, 0);
                }
            }
        }
        float ss = 0.f;
#pragma unroll
        for (int nt = 0; nt < 4; ++nt) ss += acc[nt][0] * acc[nt][0] + acc[nt][1] * acc[nt][1] + acc[nt][2] * acc[nt][2] + acc[nt][3] * acc[nt][3];
        ss += __shfl_xor(ss, 16); ss += __shfl_xor(ss, 32);
        if (lane < 16) ssq[(wave & 1) * 64 + i] = ss;
        __syncthreads();
        const float rinv = rsqrtf((ssq[i] + ssq[64 + i]) * (1.f / 128.f) + EPS);
        const float* go = KP(g_gla_norm) + (size_t)(l * 4 + h) * 128;
        u32x2 rr[4]; f32x4 gvv[4];
#pragma unroll
        for (int nt = 0; nt < 4; ++nt) { const int dv0 = (nt0 + nt) * 16 + (lane >> 4) * 4; gvv[nt] = *(const f32x4*)(go + dv0); rr[nt] = *(const u32x2*)(PA + (size_t)(row0 + i) * LDPA + 1024 + h * 128 + dv0); }
#pragma unroll
        for (int nt = 0; nt < 4; ++nt) {
            const int dv0 = (nt0 + nt) * 16 + (lane >> 4) * 4;
            const f32x4 gv = gvv[nt];
            const u32x2 r = rr[nt];
            const float o0 = acc[nt][0] * rinv * gv[0] * siluf_(bflo(r.x)), o1 = acc[nt][1] * rinv * gv[1] * siluf_(bfhi(r.x));
            const float o2 = acc[nt][2] * rinv * gv[2] * siluf_(bflo(r.y)), o3 = acc[nt][3] * rinv * gv[3] * siluf_(bfhi(r.y));
            u32x2 o; o.x = pk2(o0, o1); o.y = pk2(o2, o3);
            *(u32x2*)(PB + (size_t)(row0 + i) * LDPB + 2048 + h * 128 + dv0) = o;
        }
    }
    __syncthreads();
}

__device__ __forceinline__ void sgu_item(int l, LAS unsigned char* lds, int item) {
    const int tid = tid_(), lane = tid & 63, wave = tid >> 6;
    const int g = item & 3, ci = item >> 2; const int row0 = ci * 128;
    bf16_t* PB = (bf16_t*)(KP(ws) + WS_PB);
    LAS bf16_t* zt = (LAS bf16_t*)lds;
    LAS bf16_t* wl = (LAS bf16_t*)(lds + 34816);
    unsigned tv16[16];
#pragma unroll
    for (int jr = 0; jr < 16; ++jr) tv16[jr] = *(const unsigned*)(PB + (size_t)(row0 + wave * 16 + jr) * LDPB + 1024 + g * 128 + 2 * lane);
#pragma unroll
    for (int jr = 0; jr < 16; ++jr) { const int j = wave * 16 + jr;
        const unsigned v = tv16[jr];
        const float x0 = bflo(v), x1 = bfhi(v);
        const float mean = wave_sum(x0 + x1) * (1.f / 128.f);
        const float d0 = x0 - mean, d1 = x1 - mean;
        const float rstd = rsqrtf(wave_sum(d0 * d0 + d1 * d1) * (1.f / 128.f) + EPS);
        zt[(2 * lane) * 136 + j] = (bf16_t)f2bf(d0 * rstd); zt[(2 * lane + 1) * 136 + j] = (bf16_t)f2bf(d1 * rstd); }
    const float* W = KP(w_sgu) + (size_t)(l * 4 + g) * 128 * 128;
    {
        f32x4 tw8[8];
#pragma unroll
        for (int u = 0; u < 8; ++u) { const int idx = tid + 512 * u; tw8[u] = *(const f32x4*)(W + (idx >> 5) * 128 + (idx & 31) * 4); }
#pragma unroll
        for (int u = 0; u < 8; ++u) { const int idx = tid + 512 * u; const int i = idx >> 5, j4 = (idx & 31) * 4;
            u32x2 o; o.x = pk2(tw8[u][0], tw8[u][1]); o.y = pk2(tw8[u][2], tw8[u][3]); *(LAS u32x2*)(wl + i * 136 + j4) = o; }
    }
    __syncthreads();
    {
        const int i = wave * 16 + (lane & 15);
        f32x4 acc[8];
#pragma unroll
        for (int nt = 0; nt < 8; ++nt) acc[nt] = (f32x4){0.f, 0.f, 0.f, 0.f};
#pragma unroll
        for (int ks = 0; ks < 4; ++ks) {
            const bf16x8 a = lfrag(wl, i, 136, ks * 32 + (lane >> 4) * 8);
#pragma unroll
            for (int nt = 0; nt < 8; ++nt) {
                const bf16x8 bb = lfrag(zt, nt * 16 + (lane & 15), 136, ks * 32 + (lane >> 4) * 8);
                acc[nt] = __builtin_amdgcn_mfma_f32_16x16x32_bf16(bb, a, acc[nt], 0, 0, 0);
            }
        }
        const float bias = KP(b_sgu)[(size_t)(l * 4 + g) * 128 + i];
        u32x2 uu[8];
#pragma unroll
        for (int nt = 0; nt < 8; ++nt) uu[nt] = *(const u32x2*)(PB + (size_t)(row0 + i) * LDPB + g * 128 + nt * 16 + (lane >> 4) * 4);
#pragma unroll
        for (int nt = 0; nt < 8; ++nt) {
            const int c0 = nt * 16 + (lane >> 4) * 4;
            bf16_t* up = PB + (size_t)(row0 + i) * LDPB + g * 128 + c0;
            const u32x2 u = uu[nt];
            u32x2 o; o.x = pk2(bflo(u.x) * (acc[nt][0] + bias), bfhi(u.x) * (acc[nt][1] + bias)); o.y = pk2(bflo(u.y) * (acc[nt][2] + bias), bfhi(u.y) * (acc[nt][3] + bias));
            *(u32x2*)up = o;
        }
    }
    __syncthreads();
}

__device__ __forceinline__ void fft_item(LAS unsigned char* lds, int seg, int logN, int pair) {
    const int tid = tid_();
    const float* TW = (const float*)(KP(ws) + WS_TW);
    LAS float* re = (LAS float*)lds; LAS float* im = re + 8192; LAS float* tw = re + 16384;
    const int N = 1 << logN;
    unsigned* fc = (seg < 2) ? (unsigned*)(KP(ws) + WS_FT) + ((size_t)(seg * 256 + pair)) * 8192 : (unsigned*)(KP(ws) + WS_FTC) + ((size_t)((seg - 2) * 256 + pair)) * 256;
    unsigned* fs = (seg < 2) ? (unsigned*)(KP(ws) + WS_FOS) + ((size_t)(seg * 256 + pair)) * 8192 : (unsigned*)(KP(ws) + WS_FOSC) + ((size_t)((seg - 2) * 256 + pair)) * 256;
    {
        f32x4 tt[8];
#pragma unroll
        for (int u = 0; u < 8; ++u) { const int i = tid + 512 * u; tt[u] = (i < (N >> 1)) ? *(const f32x4*)(TW + 4 * i) : (f32x4){0.f, 0.f, 0.f, 0.f}; }
#pragma unroll
        for (int u = 0; u < 8; ++u) { const int i = tid + 512 * u; if (i < (N >> 1)) *(LAS f32x4*)(tw + 4 * i) = tt[u]; }
    }
    {
        unsigned vv[16];
#pragma unroll
        for (int u = 0; u < 16; ++u) { const int n = tid + 512 * u; vv[u] = (n < N) ? fc[n] : 0u; }
#pragma unroll
        for (int u = 0; u < 16; ++u) { const int n = tid + 512 * u;
            if (n < N) { const int r = (int)(__brev((unsigned)n) >> (32 - logN)); re[r] = bflo(vv[u]); im[r] = bfhi(vv[u]); } }
    }
    __syncthreads();
    for (int s = 1; s <= logN; ++s) {
        const int half = 1 << (s - 1);
        for (int j = tid; j < (N >> 1); j += 512) {
            const int pos = j & (half - 1); const int i0 = ((j >> (s - 1)) << s) + pos, i1 = i0 + half;
            const f32x2 w = *(const LAS f32x2*)(tw + 2 * (half - 1 + pos));
            const float xr = re[i1], xi = im[i1]; const float tr = w[0] * xr - w[1] * xi, ti = w[0] * xi + w[1] * xr;
            const float ur = re[i0], ui = im[i0];
            re[i1] = ur - tr; im[i1] = ui - ti; re[i0] = ur + tr; im[i0] = ui + ti;
        }
        __syncthreads();
    }
    const float sc = 0.5f * rsqrtf((float)N);
    for (int k = tid; k < N; k += 512) {
        const int k2 = (N - k) & (N - 1);
        const float zr = re[k], zi = im[k], yr = re[k2], yi = im[k2];
        fc[k] = pk2((zr + yr) * sc, (zi + yi) * sc);
        fs[k] = pk2((yi - zi) * sc, (zr - yr) * sc);
    }
    __syncthreads();
}
__device__ __forceinline__ void fft_transpose_items(LAS unsigned char* lds, bool with_ctx) {
    const int tid = tid_(), lane = tid & 63, wave = tid >> 6;
    LAS unsigned* scr = (LAS unsigned*)(lds + wave * 16384);
    const int gw = bid_() * 8 + wave, NGW = gridDim.x * 8;
    unsigned* FN = (unsigned*)(KP(ws) + WS_FN);
    const int nlat = 2 * 8 * 128 * 2, nctx = with_ctx ? 2 * 8 * 4 * 2 : 0;
    for (int it = gw; it < nlat + nctx; it += NGW) {
        int r = it; const bool lat = r < nlat; if (!lat) r -= nlat;
        const int cs = r & 1; r >>= 1;
        const int ntb = lat ? 128 : 4; const int tb = r % ntb; r /= ntb; const int pb = r & 7, b = r >> 3;
        const size_t Nseg = lat ? 8192 : 256;
        const unsigned* src = (const unsigned*)(KP(ws) + (lat ? (cs ? WS_FOS : WS_FT) : (cs ? WS_FOSC : WS_FTC))) + ((size_t)(b * 256 + pb * 32)) * Nseg + tb * 64 + lane;
        unsigned t[32];
#pragma unroll
        for (int i = 0; i < 32; ++i) t[i] = src[(size_t)i * Nseg];
#pragma unroll
        for (int i = 0; i < 32; ++i) scr[i * 65 + lane] = t[i];
        asm volatile("s_waitcnt lgkmcnt(0)" ::: "memory");
        const int row0 = (lat ? b * 8192 : ML + b * 256) + tb * 64;
        unsigned* dst = FN + (size_t)row0 * 512 + cs * 256 + pb * 32 + (lane & 31);
#pragma unroll
        for (int i = 0; i < 32; ++i) { const int tk = 2 * i + (lane >> 5); dst[(size_t)tk * 512] = scr[(lane & 31) * 65 + tk]; }
        asm volatile("s_waitcnt lgkmcnt(0)" ::: "memory");
    }
}

__device__ __forceinline__ void conv3_item(int l, int item) {
    const int tid = tid_();
    bf16_t* PB = (bf16_t*)(KP(ws) + WS_PB);
    const float* w = KP(w_conv) + (size_t)l * 3 * 512;
    for (int e0 = tid; e0 < 16384; e0 += 2048) {
        unsigned c0[4], x0[4], cm[4], xm[4], cq[4], xq[4], cb[4];
#pragma unroll
        for (int u = 0; u < 4; ++u) {
            const int e = e0 + 512 * u; const int row = item * 64 + (e >> 8), cp = e & 255;
            const bool lat = row < ML; const int pos = lat ? (row & 63) : ((row - ML) & 255); const int lastp = lat ? 63 : 255;
            const bf16_t* base = PB + (size_t)row * LDPB + 2 * cp;
            c0[u] = *(const unsigned*)(base + 2048); x0[u] = *(const unsigned*)(base + 2560); cb[u] = *(const unsigned*)(base + 512);
            cm[u] = 0u; xm[u] = 0u; cq[u] = 0u; xq[u] = 0u;
            if (pos > 0) { cm[u] = *(const unsigned*)(base - LDPB + 2048); xm[u] = *(const unsigned*)(base - LDPB + 2560); }
            if (pos < lastp) { cq[u] = *(const unsigned*)(base + LDPB + 2048); xq[u] = *(const unsigned*)(base + LDPB + 2560); }
        }
#pragma unroll
        for (int u = 0; u < 4; ++u) {
            const int e = e0 + 512 * u; const int row = item * 64 + (e >> 8), cp = e & 255;
            bf16_t* base = PB + (size_t)row * LDPB + 2 * cp;
            const float zl0 = bflo(cm[u]) * bflo(xm[u]), zl1 = bfhi(cm[u]) * bfhi(xm[u]), zr0 = bflo(cq[u]) * bflo(xq[u]), zr1 = bfhi(cq[u]) * bfhi(xq[u]);
            const float z0 = bflo(c0[u]) * bflo(x0[u]), z1 = bfhi(c0[u]) * bfhi(x0[u]);
            const f32x2 w0 = *(const f32x2*)(w + 2 * cp), w1 = *(const f32x2*)(w + 512 + 2 * cp), w2 = *(const f32x2*)(w + 1024 + 2 * cp);
            const float y0 = zl0 * w0[0] + z0 * w1[0] + zr0 * w2[0], y1 = zl1 * w0[1] + z1 * w1[1] + zr1 * w2[1];
            *(unsigned*)(base + 512) = pk2(bflo(cb[u]) * y0, bfhi(cb[u]) * y1);
        }
    }
}


#define XB_TMO      128
#define XB_XCNT(j)  (256  + 64 * (j))
#define XB_XSUB(j)  (1280 + 64 * (j))
#define XB_XGEN(j)  (2304 + 64 * (j))
#define XB_TOP      3328
#define XB_TOPGEN   3392
#define XB_SPIN_CAP (1u << 20)
constexpr int LDS_BARST = LDS_BYTES - 16;
__device__ __forceinline__ unsigned xb_ld(unsigned* p)              { return __hip_atomic_load(p, __ATOMIC_RELAXED, __HIP_MEMORY_SCOPE_AGENT); }
__device__ __forceinline__ unsigned xb_add(unsigned* p, unsigned v) { return __hip_atomic_fetch_add(p, v, __ATOMIC_RELAXED, __HIP_MEMORY_SCOPE_AGENT); }
__device__ __forceinline__ unsigned xb_xcc_id() { return (unsigned)__builtin_amdgcn_s_getreg((3 << 11) | 20) & 0xFu; }
#define XB_SPIN(cond, bar) do { unsigned _sp = 0; while (cond) { __builtin_amdgcn_s_sleep(1); \
    if ((++_sp & 255u) == 0u) { if (xb_ld(&(bar)[XB_TMO])) break; if (_sp > XB_SPIN_CAP) { atomicAdd(&(bar)[XB_TMO], 1u); break; } } } } while (0)
__device__ __forceinline__ void xcd_barrier_complete(unsigned* bar, unsigned x, unsigned& nloc, unsigned& nx) {
    const unsigned G = gridDim.x;
    unsigned sum, cnt, mine, sp = 0u;
    for (;;) {
        sum = 0u; cnt = 0u; mine = 0u;
#pragma unroll
        for (unsigned j = 0; j < 16; ++j) { const unsigned c = xb_ld(&bar[XB_XCNT(j)]); sum += c; cnt += (c > 0u) ? 1u : 0u; mine = (j == x) ? c : mine; }
        if (sum == G) break;
        __builtin_amdgcn_s_sleep(1);
        if ((++sp & 255u) == 0u) { if (xb_ld(&bar[XB_TMO])) break; if (sp > XB_SPIN_CAP) { atomicAdd(&bar[XB_TMO], 1u); break; } }
    }
    nloc = mine > 0u ? mine : 1u; nx = cnt > 0u ? cnt : 1u;
}
__device__ __forceinline__ void xcd_barrier(LAS unsigned char* lds) {
    asm volatile("s_waitcnt vmcnt(0) lgkmcnt(0)" ::: "memory");
    __syncthreads();
    if (tid_() == 0) {
        unsigned* bar = (unsigned*)(KP(ws) + WS_BAR);
        volatile LAS unsigned* st = (volatile LAS unsigned*)(lds + LDS_BARST);
        const unsigned x = xb_xcc_id();
        unsigned nloc = st[0], nx = st[1];
        if (nloc == 0u) { xcd_barrier_complete(bar, x, nloc, nx); st[0] = nloc; st[1] = nx; }
        const unsigned old = xb_add(&bar[XB_XSUB(x)], 1u);
        const unsigned gen = old / nloc;
        if (old + 1u == (gen + 1u) * nloc) {
            __builtin_amdgcn_fence(__ATOMIC_RELEASE, "agent");
            asm volatile("s_waitcnt vmcnt(0)" ::: "memory");
            const unsigned og = xb_add(&bar[XB_TOP], 1u);
            const unsigned tg = og / nx;
            if (og + 1u == (tg + 1u) * nx) xb_add(&bar[XB_TOPGEN], 1u);
            else XB_SPIN(xb_ld(&bar[XB_TOPGEN]) == tg, bar);
            __builtin_amdgcn_fence(__ATOMIC_ACQUIRE, "agent");
            xb_add(&bar[XB_XGEN(x)], 1u);
            asm volatile("s_waitcnt vmcnt(0)" ::: "memory");
        } else {
            XB_SPIN(xb_ld(&bar[XB_XGEN(x)]) == gen, bar);
            __builtin_amdgcn_fence(__ATOMIC_ACQUIRE, "agent");
            asm volatile("s_waitcnt vmcnt(0)" ::: "memory");
        }
    }
    __syncthreads();
}

__global__ void __launch_bounds__(512, 2) fwd_megakernel(Params p_unused) {
    extern __shared__ __attribute__((aligned(16))) unsigned char lds_raw[];
    LAS unsigned char* lds = (LAS unsigned char*)lds_raw;
    cg::grid_group grid = cg::this_grid();
#define GRID_SYNC() xcd_barrier(lds)
    const int G = gridDim.x;
    if (tid_() < 4) ((LAS unsigned*)(lds + LDS_BARST))[tid_()] = 0u;
    __syncthreads();
    if (bid_() == 0) {
        unsigned* bw = (unsigned*)(KP(ws) + WS_BAR);
        for (int i = tid_(); i < 3456; i += 512) __hip_atomic_store(bw + i, 0u, __ATOMIC_RELAXED, __HIP_MEMORY_SCOPE_AGENT);
        asm volatile("s_waitcnt vmcnt(0)" ::: "memory"); __syncthreads();
    }
    grid.sync();
    if (tid_() == 0) (void)xb_add(&((unsigned*)(KP(ws) + WS_BAR))[XB_XCNT(xb_xcc_id())], 1u);

    mods_phase(lds);
    __syncthreads();
    { float* TW = (float*)(KP(ws) + WS_TW);
      for (int k = bid_() * 512 + tid_(); k < 8191; k += G * 512) {
          const int sI = 32 - __clz(k + 1), half = 1 << (sI - 1), pos = k + 1 - half; float s, c; sincospif((float)pos / (float)half, &s, &c); TW[2 * k] = c; TW[2 * k + 1] = -s; } }
    convert_layer(0, lds);
    GRID_SYNC();

#ifndef MIXSEL
#define MIXSEL 15
#endif
#ifndef NPH
#define NPH 26
#endif
    for (int ph = 0; ph < NPH; ++ph) {
        const int l = ph / 13, k = ph % 13;
        const bool first = (l == 0);
        const int nMfull = 66, nMlat = 64;
        unsigned char* ws = KP(ws);
        if (k == 0 || k == 3 || k == 10) {
            if (k == 0 && l == 1) convert_layer(1, lds);
            const int wn = (k == 0) ? 0 : (k == 3 ? 1 : 2);
            const float* sl = (k == 0 && first) ? KP(x) : KP(out); const float* scx = (k == 0 && first) ? KP(ctx) : (const float*)(ws + WS_XC);
            const int nrows = (k == 10 && !first) ? ML : MT;
            norm_phase(sl, scx, KP(g_norm) + (size_t)(l * 3 + wn) * 1024, (const float*)(ws + WS_MOD) + (size_t)l * 3 * 9216, 3 * wn, 3 * wn + 1, (bf16_t*)(ws + WS_H), nrows,
                       (const float*)(ws + WS_PART), (k == 0 && first) ? 0 : 4, (float*)(ws + WS_XC));
        } else if (k == 1 || k == 11) {
            const int f = (k == 11);
            SchedG S; S.init(WS_H, 2048, WS_W13 + f * SZ_W13, 2048, 1024, (f && !first) ? nMlat : nMfull, 22);
            EpiSwiGLU E{ws};
            gemm_phase(lds, ws, S, E);
        } else if (k == 2 || k == 12 || k == 9) {
            const bool op = (k == 9); const int f = (k == 12);
            SchedR S; EpiResid E;
            S.op = op ? 1 : 0; S.f = f; S.nctx = op ? (first ? 32 : 0) : ((f && !first) ? 0 : 32);
            E.ws = ws; E.l = l; E.which = op ? 5 : (f ? 8 : 2); E.coef = op ? 1.f : 0.5f; E.src_in = (k == 2 && first) ? 1 : 0;
            gemm_phase(lds, ws, S, E);
        } else if (k == 4) {
            SchedG S; S.init(WS_H, 2048, WS_WIN, 2048, 1024, nMfull, 20);
            EpiInproj E{ws, l};
            gemm_phase(lds, ws, S, E);
        } else if (k == 5) {
            const int nfftL = 512, ngla = 1056, nsgu = first ? 528 : 512, ncv = first ? 264 : 256, nfftS = first ? 512 : 0;
            const int total = nfftL + ngla + nsgu + ncv + nfftS;
            for (int it = bid_(); it < total; it += G) {
                int r = it;
                if (r < nfftL) { fft_item(lds, r >> 8, 13, r & 255); continue; } r -= nfftL;
                if (r < ngla) { gla1_item(lds, r); continue; } r -= ngla;
                if (r < nsgu) { sgu_item(l, lds, r); continue; } r -= nsgu;
                if (r < ncv) { conv3_item(l, r); continue; } r -= ncv;
                fft_item(lds, 2 + (r >> 8), 8, r & 255);
            }
        } else if (k == 6) {
            gla_scan();
            fft_transpose_items(lds, first);
        } else if (k == 7) {
            if (MIXSEL & 1) for (int it = bid_(); it < 1056; it += G) { if (!first && (it % 132) < 4) continue; gla3_item(l, lds, it); }
        } else if (k == 8) {
            SchedM S; S.nlat = 256; S.nctx = first ? 32 : 0; S.G = G; S.c = bid_();
            EpiMerge E{ws, l};
            gemm_phase(lds, ws, S, E);
        }
        GRID_SYNC();
    }
    final_norm(KP(out), KP(g_final));
}

extern "C" void kernel_launch(void* const* d_in, const int* in_sizes, int n_in, void* d_out, int out_size, void* d_ws, size_t ws_size, hipStream_t stream) {
    static int grid = 0;
    if (grid == 0) {
        if (ws_size < WS_END) { fprintf(stderr, "kernel_launch: workspace too small: %zu < %zu\n", ws_size, (size_t)WS_END); grid = -1; return; }
        int dev = 0, cus = 0, per_cu = 0;
        hipGetDevice(&dev);
        hipDeviceGetAttribute(&cus, hipDeviceAttributeMultiprocessorCount, dev);
        if (hipFuncSetAttribute((const void*)fwd_megakernel, hipFuncAttributeMaxDynamicSharedMemorySize, LDS_BYTES) != hipSuccess) { fprintf(stderr, "kernel_launch: hipFuncSetAttribute failed\n"); grid = -1; return; }
        if (hipOccupancyMaxActiveBlocksPerMultiprocessor(&per_cu, (const void*)fwd_megakernel, 512, LDS_BYTES) != hipSuccess || per_cu < 1) { fprintf(stderr, "kernel_launch: occupancy query gave %d\n", per_cu); per_cu = 1; }
        (void)hipGetLastError();
        grid = cus * per_cu;
    }
    if (grid < 0) return;
    Params p{};
    const float** pp = (const float**)&p;
    for (int i = 0; i < 22; ++i) pp[i] = (const float*)d_in[i];
    p.out = (float*)d_out; p.ws = (unsigned char*)d_ws;
    void* args[] = {&p};
    hipError_t e = hipLaunchCooperativeKernel((const void*)fwd_megakernel, dim3(grid), dim3(512), args, LDS_BYTES, stream);
    if (e != hipSuccess) fprintf(stderr, "cooperative launch failed: %s (grid %d)\n", hipGetErrorString(e), grid);
}
```

```cpp
#include <hip/hip_runtime.h>
#include <hip/hip_cooperative_groups.h>
#include <cstdio>
namespace cg = cooperative_groups;

#define LAS __attribute__((address_space(3)))
typedef unsigned short bf16_t;
typedef short bf16x8 __attribute__((ext_vector_type(8)));
typedef float f32x4 __attribute__((ext_vector_type(4)));
typedef float f32x2 __attribute__((ext_vector_type(2)));
typedef unsigned u32x4 __attribute__((ext_vector_type(4)));
typedef unsigned u32x2 __attribute__((ext_vector_type(2)));

constexpr int ML = 16384, MT = 16896, DM = 1024, FF = 2816;
constexpr int LDPA = 2048, LDPB = 3072;
constexpr int LDS_BYTES = 147456;
constexpr float EPS = 1e-6f;

constexpr size_t SZ_W13 = (size_t)5632 * 1024 * 2, SZ_W2 = (size_t)1024 * 2816 * 2;
constexpr size_t WS_W13 = 0;
constexpr size_t WS_W2 = WS_W13 + 2 * SZ_W13;
constexpr size_t WS_WIN = WS_W2 + 2 * SZ_W2;
constexpr size_t WS_WG = WS_WIN + (size_t)5120 * 1024 * 2;
constexpr size_t WS_WB = WS_WG + (size_t)4096 * 1024 * 2;
constexpr size_t WS_WO = WS_WB + (size_t)5 * 1024 * 1024;
constexpr size_t WS_XC = WS_WO + (size_t)1024 * 1024 * 2;
constexpr size_t WS_H = WS_XC + (size_t)512 * 1024 * 4;
constexpr size_t WS_PA = WS_H + (size_t)MT * 1024 * 2;
constexpr size_t WS_PB = WS_PA + (size_t)MT * 2048 * 2;
constexpr size_t WS_FN = WS_PB + (size_t)MT * 3072 * 2;
constexpr size_t WS_S = WS_FN + (size_t)MT * 1024 * 2;
constexpr size_t WS_DT = WS_S + (size_t)16 * 132 * 8192 * 2;
constexpr size_t WS_MOD = WS_DT + (size_t)16 * 132 * 64 * 4;
constexpr size_t WS_TW = WS_MOD + (size_t)2 * 3 * 9216 * 4;
constexpr size_t WS_BAR = WS_TW + 65536;
constexpr size_t WS_GS = WS_BAR + 16384;
constexpr size_t WS_END = WS_GS + (size_t)MT * 1024 * 2;

struct Params {
    const float *x, *c, *ctx, *c_ctx, *w_ada, *b_ada, *g_norm, *w_ff1, *w_ff3, *w_ff2, *w_in, *w_gla_a2, *b_gla_a2, *g_gla_norm,
        *w_sgu, *b_sgu, *w_conv, *w_branch, *w_gate, *b_gate, *w_out, *g_final;
    float* out; unsigned char* ws;
};

typedef const __attribute__((address_space(4))) Params* KPtr;
__device__ __forceinline__ KPtr getkp() { KPtr q = (KPtr)__builtin_amdgcn_kernarg_segment_ptr(); asm volatile("" : "+s"(q)); return q; }
#define KP(f) (getkp()->f)
__device__ __forceinline__ int tid_() { int t = threadIdx.x; asm volatile("" : "+v"(t)); return t; }
__device__ __forceinline__ int bid_() { int b = blockIdx.x; asm volatile("" : "+s"(b)); return b; }
__device__ __forceinline__ unsigned f2bf(float f) { unsigned u = __float_as_uint(f); return (u + 0x7fffu + ((u >> 16) & 1u)) >> 16; }
__device__ __forceinline__ unsigned pk2(float lo, float hi) { return f2bf(lo) | (f2bf(hi) << 16); }
__device__ __forceinline__ float bflo(unsigned u) { return __uint_as_float(u << 16); }
__device__ __forceinline__ float bfhi(unsigned u) { return __uint_as_float(u & 0xffff0000u); }
__device__ __forceinline__ float bf2f(bf16_t b) { return __uint_as_float(((unsigned)b) << 16); }
__device__ __forceinline__ unsigned cvt_pk_bf16(float lo, float hi) { unsigned r; asm volatile("s_nop 1\n\tv_cvt_pk_bf16_f32 %0, %1, %2" : "=v"(r) : "v"(lo), "v"(hi)); return r; }
__device__ __forceinline__ float wave_sum(float v) {
#pragma unroll
    for (int o = 1; o < 64; o <<= 1) v += __shfl_xor(v, o);
    return v;
}
__device__ __forceinline__ float sigmoidf_(float x) { return __builtin_amdgcn_rcpf(1.f + __expf(-x)); }
__device__ __forceinline__ float siluf_(float x) { return x * sigmoidf_(x); }
__device__ __forceinline__ bf16x8 lfrag(const LAS bf16_t* base, int row, int ld, int k) { return *(const LAS bf16x8*)(base + row * ld + k); }

constexpr int HTB = 128 * 64 * 2;
__device__ __forceinline__ int lds_byte(int r, int c) { const int st = (r >> 4) * 2 + (c >> 5), rr = r & 15, cc = c & 31, ob = rr * 64 + cc * 2; return st * 1024 + (ob ^ (((ob >> 9) & 1) << 5)); }
__device__ __forceinline__ void stage_rc(int b, int& R, int& C) { const int st = b / 1024, sb = b % 1024, swz = sb ^ (((sb >> 9) & 1) << 5); R = (st >> 1) * 16 + swz / 64; C = (st & 1) * 32 + (swz % 64) / 2; }
__device__ __forceinline__ int perm32(int rho) { const int n = rho >> 4, i = rho & 15; return 8 * (i >> 2) + 4 * n + (i & 3); }

struct Unit { unsigned A, B, lda2, ldb2; int nt, pm, pn, kind; };

template <class Epi, class Sched>
__device__ __forceinline__ void gemm_phase(LAS unsigned char* lds, const unsigned char* wsb, const Sched& S, const Epi& E) {
    const int tid = tid_(), wid = __builtin_amdgcn_readfirstlane(tid >> 6), lane = tid & 63, wr = wid >> 2, wc = wid & 3, fr = lane & 15, fq = lane >> 4;
    unsigned Ra0, Rb0, Cc0;
    { int R, C; stage_rc(tid * 16, R, C); Ra0 = (unsigned)R; Rb0 = (unsigned)((R & ~31) + perm32(R & 31)); Cc0 = (unsigned)C * 2u; }
    const unsigned ldsw = (unsigned)wid * 1024u;
    const int aoff = lds_byte(wr * 64 + fr, fq * 8), boff = lds_byte(wc * 32 + fr, fq * 8);
#define G_SA(b, h) (((b) * 2 + (h)) * HTB)
#define G_SB(b, h) ((4 + (b) * 2 + (h)) * HTB)
#define G_STAGE_A(bufoff, uoff, ld) do { const unsigned _o = Ra0 * (ld) + (Cc0 + (uoff)); \
        __builtin_amdgcn_global_load_lds((const unsigned*)(wsb + (size_t)_o), (LAS unsigned*)(lds + (bufoff) + ldsw), 16, 0, 0); \
        __builtin_amdgcn_global_load_lds((const unsigned*)(wsb + (size_t)(_o + 64u * (ld))), (LAS unsigned*)(lds + (bufoff) + ldsw + 8192), 16, 0, 0); } while (0)
#define G_STAGE_B(bufoff, uoff, ld) do { const unsigned _o = Rb0 * (ld) + (Cc0 + (uoff)); \
        __builtin_amdgcn_global_load_lds((const unsigned*)(wsb + (size_t)_o), (LAS unsigned*)(lds + (bufoff) + ldsw), 16, 0, 0); \
        __builtin_amdgcn_global_load_lds((const unsigned*)(wsb + (size_t)(_o + 64u * (ld))), (LAS unsigned*)(lds + (bufoff) + ldsw + 8192), 16, 0, 0); } while (0)
#define G_LDA(dst, b, h) do { _Pragma("unroll") for (int m = 0; m < 4; ++m) _Pragma("unroll") for (int k = 0; k < 2; ++k) dst[m][k] = *(const LAS bf16x8*)(lds + G_SA(b, h) + aoff + m * 2048 + k * 1024); } while (0)
#define G_LDB(dst, b, h) do { _Pragma("unroll") for (int n = 0; n < 2; ++n) _Pragma("unroll") for (int k = 0; k < 2; ++k) dst[n][k] = *(const LAS bf16x8*)(lds + G_SB(b, h) + boff + n * 2048 + k * 1024); } while (0)
#define G_MMA(ai, bj, At, Bt) do { __builtin_amdgcn_s_setprio(1); _Pragma("unroll") for (int m = 0; m < 4; ++m) _Pragma("unroll") for (int n = 0; n < 2; ++n) _Pragma("unroll") for (int k = 0; k < 2; ++k) \
        acc[ai][bj][m][n] = __builtin_amdgcn_mfma_f32_16x16x32_bf16(Bt[n][k], At[m][k], acc[ai][bj][m][n], 0, 0, 0); __builtin_amdgcn_s_setprio(0); } while (0)
#define G_WAIT_V(n) asm volatile("s_waitcnt vmcnt(" #n ")" ::: "memory")
#define G_WAIT_L(n) asm volatile("s_waitcnt lgkmcnt(" #n ")" ::: "memory")
#define G_BAR __builtin_amdgcn_s_barrier()
#define G_SCHED __builtin_amdgcn_sched_barrier(0)
    Unit cur, nxt; int ui = 0;
    if (!S.next(0, cur)) return;
    f32x4 acc[2][2][4][2];
    bf16x8 At[4][2], B0[2][2], B1[2][2];
    {
        const unsigned cA = cur.A, cB = cur.B, la = cur.lda2, lb = cur.ldb2, hA = 128u * la, hB = 128u * lb;
        G_STAGE_B(G_SB(0, 0), cB, lb); G_STAGE_A(G_SA(0, 0), cA, la); G_STAGE_B(G_SB(0, 1), cB + hB, lb); G_STAGE_A(G_SA(0, 1), cA + hA, la);
        if (wr == 1) G_BAR;
        G_WAIT_V(4); G_BAR;
        G_STAGE_B(G_SB(1, 0), cB + 128u, lb); G_STAGE_A(G_SA(1, 0), cA + 128u, la); G_STAGE_B(G_SB(1, 1), cB + hB + 128u, lb);
        G_WAIT_V(6); G_BAR;
    }
    for (;;) {
#pragma unroll
        for (int a = 0; a < 2; ++a)
#pragma unroll
            for (int b = 0; b < 2; ++b)
#pragma unroll
                for (int m = 0; m < 4; ++m)
#pragma unroll
                    for (int n = 0; n < 2; ++n) acc[a][b][m][n] = (f32x4){0.f, 0.f, 0.f, 0.f};
        const bool has_next = S.next(ui + 1, nxt);
        if (!has_next) nxt = cur;
        const unsigned cA = cur.A, cB = cur.B, la = cur.lda2, lb = cur.ldb2;
        const int nt = cur.nt;
        for (int t = 0; t < nt; t += 2) {
            const bool last = (t == nt - 2);
            const unsigned a1 = cA + (unsigned)(t + 1) * 128u;
            const unsigned a2 = last ? nxt.A : cA + (unsigned)(t + 2) * 128u, b2 = last ? nxt.B : cB + (unsigned)(t + 2) * 128u;
            const unsigned la2 = last ? nxt.lda2 : la, lb2 = last ? nxt.ldb2 : lb;
            const unsigned a3 = a2 + 128u, b3 = b2 + 128u;
            G_LDB(B0, 0, 0); G_SCHED; G_LDA(At, 0, 0); G_STAGE_A(G_SA(1, 1), a1 + 128u * la, la);
            G_WAIT_L(8); G_BAR; G_WAIT_L(0); G_MMA(0, 0, At, B0); G_BAR; G_SCHED;
            G_LDB(B1, 0, 1); G_STAGE_B(G_SB(0, 0), b2, lb2);
            G_BAR; G_WAIT_L(0); G_MMA(0, 1, At, B1); G_BAR;
            G_LDA(At, 0, 1); G_STAGE_A(G_SA(0, 0), a2, la2);
            G_BAR; G_WAIT_L(0); G_MMA(1, 0, At, B0); G_BAR; G_SCHED;
            G_STAGE_B(G_SB(0, 1), b2 + 128u * lb2, lb2);
            G_WAIT_V(6); G_BAR; G_MMA(1, 1, At, B1); G_BAR;
            G_LDB(B0, 1, 0); G_SCHED; G_LDA(At, 1, 0); G_STAGE_A(G_SA(0, 1), a2 + 128u * la2, la2);
            G_WAIT_L(8); G_BAR; G_WAIT_L(0); G_MMA(0, 0, At, B0); G_BAR; G_SCHED;
            G_LDB(B1, 1, 1); G_STAGE_B(G_SB(1, 0), b3, lb2);
            G_BAR; G_WAIT_L(0); G_MMA(0, 1, At, B1); G_BAR;
            G_LDA(At, 1, 1); G_STAGE_A(G_SA(1, 0), a3, la2);
            G_BAR; G_WAIT_L(0); G_MMA(1, 0, At, B0); G_BAR; G_SCHED;
            G_STAGE_B(G_SB(1, 1), b3 + 128u * lb2, lb2);
            G_WAIT_V(6); G_BAR; G_MMA(1, 1, At, B1); G_BAR;
        }
        { int fr2 = fr, fq2 = fq; asm volatile("" : "+v"(fr2), "+v"(fq2));
          E(acc, cur, wr, wc, fr2, fq2); }
        if (!has_next) break;
        cur = nxt; ++ui;
    }
    G_WAIT_V(0);
    if (wr == 0) G_BAR;
    G_BAR;
#undef G_SA
#undef G_SB
#undef G_STAGE_A
#undef G_STAGE_B
#undef G_LDA
#undef G_LDB
#undef G_MMA
#undef G_WAIT_V
#undef G_WAIT_L
#undef G_BAR
#undef G_SCHED
}

struct SchedG {
    unsigned A, B, lda2, ldb2; int nt, nM, nN, nwg, G, c;
    __device__ __forceinline__ void init(size_t A_, unsigned lda2_, size_t B_, unsigned ldb2_, int K, int nM_, int nN_) {
        A = (unsigned)A_; B = (unsigned)B_; lda2 = lda2_; ldb2 = ldb2_; nt = K / 64; nM = nM_; nN = nN_; nwg = nM * nN; G = gridDim.x; c = bid_(); }
    __device__ __forceinline__ bool next(int i, Unit& u) const {
        const int L = i * G + c; if (L >= nwg) return false;
        int wgid = L; { const int q = nwg / 8, r = nwg % 8, xcd = wgid % 8, off = wgid / 8; wgid = (xcd < r ? xcd * (q + 1) : r * (q + 1) + (xcd - r) * q) + off; }
        const int nig = 8 * nN, gid = wgid / nig, fm = gid * 8, gsz = (nM - fm) < 8 ? (nM - fm) : 8;
        u.pm = fm + ((wgid % nig) % gsz); u.pn = (wgid % nig) / gsz;
        u.A = A + (unsigned)u.pm * 256u * lda2; u.B = B + (unsigned)u.pn * 256u * ldb2; u.lda2 = lda2; u.ldb2 = ldb2; u.nt = nt; u.kind = 0; return true;
    }
};
constexpr size_t WS_TBUF = WS_S;
constexpr size_t WS_GSC = WS_S + (size_t)4 * 1048576;
constexpr size_t WS_PART = WS_FN;
constexpr size_t WS_FT = WS_GS, WS_FTC = WS_GS + (size_t)2 * 256 * 8192 * 4, WS_FOS = WS_FTC + (size_t)2 * 256 * 256 * 4, WS_FOSC = WS_FOS + (size_t)2 * 256 * 8192 * 4;
struct SchedM {
    int nlat, nctx, G, c;
    __device__ __forceinline__ void fill(Unit& u, int pm, int pn, int k, int isb) const {
        u.pm = pm; u.pn = pn;
        if (!isb) { u.A = (unsigned)WS_H + (unsigned)pm * 256u * 2048u; u.lda2 = 2048; u.B = (unsigned)WS_WG + (unsigned)(k * 1024 + pn * 256) * 2048u; u.ldb2 = 2048; u.nt = 16; }
        else if (k == 2) { u.A = (unsigned)WS_FN + (unsigned)pm * 256u * 2048u; u.lda2 = 2048; u.B = (unsigned)WS_WB + 3u * 1048576u + (unsigned)pn * 256u * 2048u; u.ldb2 = 2048; u.nt = 16; }
        else { const unsigned colb = (k == 0) ? 4096u : (k == 1 ? 0u : 1024u); const unsigned wb = (k == 0) ? 0u : (k == 1 ? 1u : 2u);
            u.A = (unsigned)WS_PB + (unsigned)pm * 256u * 6144u + colb; u.lda2 = 6144; u.B = (unsigned)WS_WB + wb * 1048576u + (unsigned)pn * 256u * 1024u; u.ldb2 = 1024; u.nt = 8; }
    }
    __device__ __forceinline__ bool next(int i, Unit& u) const {
        const int nl = (c < nlat) ? (nlat - c + G - 1) / G : 0;
        const int vc = (G % 8 == 0) ? (c % 8) * (G / 8) + c / 8 : c;
        if (i < 8 * nl) { const int ti = i >> 3, sub = i & 7, id = ti * G + vc; u.kind = sub; fill(u, id >> 2, id & 3, sub >> 1, sub & 1); return true; }
        const int j = i - 8 * nl;
        if (c < nctx && j < 2) { const int t = c >> 2, k = c & 3; u.kind = 16 + 2 * k + j; fill(u, 64 + (t >> 2), t & 3, k, j); return true; }
        return false;
    }
};
struct SchedR {
    int op, f, nctx;
    __device__ __forceinline__ bool next(int i, Unit& u) const {
        const int L = i * (int)gridDim.x + (int)blockIdx.x;
        const unsigned A = op ? (unsigned)(WS_PB + 2048) : (unsigned)WS_PA, lda2 = op ? 6144u : 5632u;
        const unsigned B = op ? (unsigned)WS_WO : (unsigned)(WS_W2 + f * SZ_W2), ldb2 = op ? 2048u : 5632u;
        const bool islat = (L < 256);
        const int j = L - 256;
        if (!islat && j >= nctx) return false;
        const int xw = (L % 8) * 32 + (L / 8), gid = xw / 32;
        const int t = j >> 2, sp = j & 3;
        const int pm = islat ? gid * 8 + ((xw % 32) % 8) : 64 + (t >> 2);
        const int pn = islat ? (xw % 32) / 8 : (t & 3);
        const int k0 = (islat || op) ? 0 : 12 * sp - 2 * (sp >> 1) * (sp & 1);
        const int nt = op ? 16 : (islat ? 44 : 12 - 2 * (sp >> 1));
        const bool tb = (!islat && op);
        u.pm = pm; u.pn = pn; u.kind = islat ? 0 : sp; u.nt = nt; u.ldb2 = ldb2; u.lda2 = tb ? 2048u : lda2;
        u.A = tb ? (unsigned)WS_TBUF + (unsigned)sp * 1048576u + (unsigned)(pm - 64) * 256u * 2048u : A + (unsigned)pm * 256u * lda2 + (unsigned)k0 * 128u;
        u.B = B + (unsigned)pn * 256u * ldb2 + (unsigned)k0 * 128u;
        return true;
    }
};

struct EpiSwiGLU {
    unsigned char* ws;
    __device__ __forceinline__ void operator()(const f32x4 (&acc)[2][2][4][2], const Unit& u, int wr, int wc, int fr, int fq) const {
        bf16_t* U = (bf16_t*)(ws + WS_PA);
        const int row0 = u.pm * 256 + wr * 64 + fr, col0 = u.pn * 128 + wc * 32 + 8 * fq;
#pragma unroll
        for (int ai = 0; ai < 2; ++ai)
#pragma unroll
            for (int m = 0; m < 4; ++m) {
                const f32x4 a0 = acc[ai][0][m][0], a1 = acc[ai][0][m][1], b0 = acc[ai][1][m][0], b1 = acc[ai][1][m][1];
                u32x4 w;
                w.x = cvt_pk_bf16(siluf_(a0[0]) * b0[0], siluf_(a0[1]) * b0[1]); w.y = cvt_pk_bf16(siluf_(a0[2]) * b0[2], siluf_(a0[3]) * b0[3]);
                w.z = cvt_pk_bf16(siluf_(a1[0]) * b1[0], siluf_(a1[1]) * b1[1]); w.w = cvt_pk_bf16(siluf_(a1[2]) * b1[2], siluf_(a1[3]) * b1[3]);
                *(u32x4*)(U + (size_t)(row0 + ai * 128 + m * 16) * FF + col0) = w;
            }
    }
};
struct EpiResid {
    unsigned char* ws; int l, which, src_in; float coef;
    __device__ __forceinline__ void operator()(const f32x4 (&acc)[2][2][4][2], const Unit& u, int wr, int wc, int fr, int fq) const {
        const int row0 = u.pm * 256 + wr * 64 + fr, col0 = u.pn * 256 + wc * 32 + 8 * fq;
        const int mid = u.pm < 32 ? 0 : (u.pm < 64 ? 1 : 2);
        const float* gp = (const float*)(ws + WS_MOD) + (size_t)((l * 3 + mid) * 9 + which) * 1024 + col0;
        const bool isctx = (u.pm >= 64);
        float* dst = !isctx ? KP(out) + (size_t)row0 * 1024 : (float*)(ws + WS_PART) + (size_t)u.kind * 524288 + (size_t)(row0 - ML) * 1024;
        const float* src = dst;
        if (src_in && !isctx) src = KP(x) + (size_t)row0 * 1024;
        f32x4 gv[2][2];
#pragma unroll
        for (int bj = 0; bj < 2; ++bj)
#pragma unroll
            for (int n = 0; n < 2; ++n) gv[bj][n] = *(const f32x4*)(gp + bj * 128 + 4 * n) * coef;
#pragma unroll
        for (int aim = 0; aim < 4; ++aim) { const int ai = aim >> 1, m0 = (aim & 1) * 2;
            f32x4 rs[4][2][2];
#pragma unroll
            for (int m = m0; m < m0 + 2; ++m)
#pragma unroll
                for (int bj = 0; bj < 2; ++bj)
#pragma unroll
                    for (int n = 0; n < 2; ++n) { const size_t ro = (size_t)(ai * 128 + m * 16) * 1024; const int col = col0 + bj * 128 + 4 * n;
                        rs[m][bj][n] = isctx ? (f32x4){0.f, 0.f, 0.f, 0.f} : *(const f32x4*)(src + ro + col); }
#pragma unroll
            for (int m = m0; m < m0 + 2; ++m)
#pragma unroll
                for (int bj = 0; bj < 2; ++bj)
#pragma unroll
                    for (int n = 0; n < 2; ++n) { const size_t ro = (size_t)(ai * 128 + m * 16) * 1024; const int col = col0 + bj * 128 + 4 * n;
                        *(f32x4*)(dst + ro + col) = rs[m][bj][n] + gv[bj][n] * acc[ai][bj][m][n]; }
        }
    }
};
__device__ __forceinline__ float logdecay(float x) { return (fminf(x, 0.f) - __logf(1.f + __expf(-fabsf(x)))) * (1.f / 16.f); }
struct EpiInproj {
    unsigned char* ws; int l;
    __device__ __forceinline__ void operator()(const f32x4 (&acc)[2][2][4][2], const Unit& u, int wr, int wc, int fr, int fq) const {
        const int row0 = u.pm * 256 + wr * 64 + fr, cl0 = wc * 32 + 8 * fq;
        bf16_t* base; int ld;
        if (u.pn < 8) { base = (bf16_t*)(ws + WS_PA) + u.pn * 256; ld = LDPA; } else { base = (bf16_t*)(ws + WS_PB) + (u.pn - 8) * 256; ld = LDPB; }
        const bool dec = (u.pn == 6 || u.pn == 7);
        const float scl = (u.pn == 0) ? 0.125f : 1.f;
        f32x4 bv[2][2];
#pragma unroll
        for (int bj = 0; bj < 2; ++bj)
#pragma unroll
            for (int n = 0; n < 2; ++n) bv[bj][n] = (f32x4){0.f, 0.f, 0.f, 0.f};
        if (dec) { const float* b_a2 = KP(b_gla_a2) + (size_t)l * 512 + (u.pn - 6) * 256 + cl0;
#pragma unroll
            for (int bj = 0; bj < 2; ++bj)
#pragma unroll
                for (int n = 0; n < 2; ++n) bv[bj][n] = *(const f32x4*)(b_a2 + bj * 128 + 4 * n); }
#pragma unroll
        for (int ai = 0; ai < 2; ++ai)
#pragma unroll
            for (int m = 0; m < 4; ++m) {
                bf16_t* rowp = base + (size_t)(row0 + ai * 128 + m * 16) * ld + cl0;
#pragma unroll
                for (int bj = 0; bj < 2; ++bj) {
                    f32x4 v0 = acc[ai][bj][m][0], v1 = acc[ai][bj][m][1];
                    if (dec) {
                        v0 = v0 + bv[bj][0]; v1 = v1 + bv[bj][1];
#pragma unroll
                        for (int j = 0; j < 4; ++j) { v0[j] = logdecay(v0[j]); v1[j] = logdecay(v1[j]); }
                    } else { v0 = v0 * scl; v1 = v1 * scl; }
                    u32x4 w; w.x = cvt_pk_bf16(v0[0], v0[1]); w.y = cvt_pk_bf16(v0[2], v0[3]); w.z = cvt_pk_bf16(v1[0], v1[1]); w.w = cvt_pk_bf16(v1[2], v1[3]);
                    if (u.pn == 14 || u.pn == 15) {
                        const int row = row0 + ai * 128 + m * 16; const int pair0 = (u.pn - 14) * 128 + bj * 64 + (cl0 >> 1);
                        unsigned* ft = (row < ML) ? (unsigned*)(ws + WS_FT) + ((size_t)((row >> 13) * 256 + pair0)) * 8192 + (row & 8191)
                                                  : (unsigned*)(ws + WS_FTC) + ((size_t)(((row - ML) >> 8) * 256 + pair0)) * 256 + ((row - ML) & 255);
                        const size_t ps = (row < ML) ? 8192 : 256;
                        ft[0] = w.x; ft[ps] = w.y; ft[2 * ps] = w.z; ft[3 * ps] = w.w;
                    } else *(u32x4*)(rowp + bj * 128) = w;
                }
            }
    }
};
struct EpiMerge {
    unsigned char* ws; int l;
    __device__ __forceinline__ void operator()(const f32x4 (&acc)[2][2][4][2], const Unit& u, int wr, int wc, int fr, int fq) const {
        const int row0 = u.pm * 256 + wr * 64 + fr, col0 = u.pn * 256 + wc * 32 + 8 * fq;
        const bool isctx = (u.kind >= 16);
        const int k = (u.kind & 15) >> 1;
        bf16_t* Gs = isctx ? (bf16_t*)(ws + WS_GSC) + (size_t)k * 524288 - (size_t)ML * 1024 : (bf16_t*)(ws + WS_GS);
        if (!(u.kind & 1)) {
            const float* b_gate = KP(b_gate) + (size_t)l * 4096 + k * 1024 + col0;
            f32x4 bv[2][2];
#pragma unroll
            for (int bj = 0; bj < 2; ++bj)
#pragma unroll
                for (int n = 0; n < 2; ++n) bv[bj][n] = *(const f32x4*)(b_gate + bj * 128 + 4 * n);
#pragma unroll
            for (int ai = 0; ai < 2; ++ai)
#pragma unroll
                for (int m = 0; m < 4; ++m) {
                    bf16_t* rowp = Gs + (size_t)(row0 + ai * 128 + m * 16) * 1024 + col0;
#pragma unroll
                    for (int bj = 0; bj < 2; ++bj) {
                        const f32x4 v0 = acc[ai][bj][m][0] + bv[bj][0], v1 = acc[ai][bj][m][1] + bv[bj][1];
                        u32x4 w; w.x = cvt_pk_bf16(sigmoidf_(v0[0]), sigmoidf_(v0[1])); w.y = cvt_pk_bf16(sigmoidf_(v0[2]), sigmoidf_(v0[3]));
                        w.z = cvt_pk_bf16(sigmoidf_(v1[0]), sigmoidf_(v1[1])); w.w = cvt_pk_bf16(sigmoidf_(v1[2]), sigmoidf_(v1[3]));
                        *(u32x4*)(rowp + bj * 128) = w;
                    }
                }
        } else {
            bf16_t* Macc = (bf16_t*)(ws + WS_PA); bf16_t* Mb = (bf16_t*)(ws + WS_PB) + 1024;
#pragma unroll
            for (int aim = 0; aim < 4; ++aim) { const int ai = aim >> 1, m0 = (aim & 1) * 2;
                u32x4 gg[4][2]; u32x4 mq[4][2];
#pragma unroll
                for (int m = m0; m < m0 + 2; ++m)
#pragma unroll
                    for (int bj = 0; bj < 2; ++bj) {
                        const size_t row = (size_t)(row0 + ai * 128 + m * 16); const int col = col0 + bj * 128;
                        gg[m][bj] = *(const u32x4*)(Gs + row * 1024 + col);
                        if (!isctx && k > 0) mq[m][bj] = *(const u32x4*)(Macc + row * 1024 + col);
                        else mq[m][bj] = (u32x4){0u, 0u, 0u, 0u};
                    }
#pragma unroll
                for (int m = m0; m < m0 + 2; ++m) {
                    const size_t row = (size_t)(row0 + ai * 128 + m * 16);
#pragma unroll
                    for (int bj = 0; bj < 2; ++bj) {
                        const int col = col0 + bj * 128;
                        const u32x4 g = gg[m][bj];
                        f32x4 t0 = acc[ai][bj][m][0], t1 = acc[ai][bj][m][1];
                        t0[0] *= bflo(g.x); t0[1] *= bfhi(g.x); t0[2] *= bflo(g.y); t0[3] *= bfhi(g.y);
                        t1[0] *= bflo(g.z); t1[1] *= bfhi(g.z); t1[2] *= bflo(g.w); t1[3] *= bfhi(g.w);
                        if (isctx) { u32x4 w; w.x = cvt_pk_bf16(t0[0], t0[1]); w.y = cvt_pk_bf16(t0[2], t0[3]); w.z = cvt_pk_bf16(t1[0], t1[1]); w.w = cvt_pk_bf16(t1[2], t1[3]);
                            *(u32x4*)((bf16_t*)(ws + WS_TBUF) + (size_t)k * 524288 + (row - ML) * 1024 + col) = w; continue; }
                        bf16_t* mp = Macc + row * 1024 + col;
                        { const u32x4 q = mq[m][bj];
                          t0[0] += bflo(q.x); t0[1] += bfhi(q.x); t0[2] += bflo(q.y); t0[3] += bfhi(q.y); t1[0] += bflo(q.z); t1[1] += bfhi(q.z); t1[2] += bflo(q.w); t1[3] += bfhi(q.w); }
                        if (k < 3) { u32x4 w; w.x = cvt_pk_bf16(t0[0], t0[1]); w.y = cvt_pk_bf16(t0[2], t0[3]); w.z = cvt_pk_bf16(t1[0], t1[1]); w.w = cvt_pk_bf16(t1[2], t1[3]); *(u32x4*)mp = w; }
                        else { u32x4 w; w.x = cvt_pk_bf16(t0[0], t0[1]); w.y = cvt_pk_bf16(t0[2], t0[3]); w.z = cvt_pk_bf16(t1[0], t1[1]); w.w = cvt_pk_bf16(t1[2], t1[3]);
                            *(u32x4*)(Mb + row * LDPB + col) = w; }
                    }
                }
            }
        }
    }
};

__device__ __forceinline__ void conv_item(const float* W, int ldw, int src_col0, bf16_t* WT, int ldt, int dst_row0, int k0, LAS float* scr, int lane) {
    {
        const int r8 = lane >> 3, c4 = (lane & 7) * 4;
        f32x4 t[8];
#pragma unroll
        for (int i = 0; i < 8; ++i) t[i] = __builtin_nontemporal_load((const f32x4*)(W + (size_t)(k0 + 8 * i + r8) * ldw + src_col0 + c4));
#pragma unroll
        for (int i = 0; i < 8; ++i) { LAS float* d = scr + (8 * i + r8) * 33 + c4; d[0] = t[i][0]; d[1] = t[i][1]; d[2] = t[i][2]; d[3] = t[i][3]; }
    }
    asm volatile("s_waitcnt lgkmcnt(0)" ::: "memory");
    const int c = lane & 7;
#pragma unroll
    for (int j = 0; j < 4; ++j) { const int n = (lane >> 3) + 8 * j; const LAS float* s = scr + (8 * c) * 33 + n;
        u32x4 o; o.x = pk2(s[0 * 33], s[1 * 33]); o.y = pk2(s[2 * 33], s[3 * 33]); o.z = pk2(s[4 * 33], s[5 * 33]); o.w = pk2(s[6 * 33], s[7 * 33]);
        *(u32x4*)(WT + (size_t)(dst_row0 + n) * ldt + k0 + 8 * c) = o; }
    asm volatile("s_waitcnt lgkmcnt(0)" ::: "memory");
}

__device__ __forceinline__ void convert_layer(int l, LAS unsigned char* lds) {
    const int tid = tid_(), lane = tid & 63, wave = tid >> 6;
    LAS float* scr = (LAS float*)(lds + wave * 16384);
    unsigned char* ws = KP(ws);
    const int gw = bid_() * 8 + wave, NGW = gridDim.x * 8;
    constexpr int I_FF = 16 * 88, I_F2 = 44 * 32, I_INA = 16 * 48, I_INB = 16 * 96, I_G = 16 * 32, I_B = 8 * 32, I_O = 16 * 32;
    constexpr int NIT = 4 * I_FF + 2 * I_F2 + I_INA + I_INB + 4 * I_G + 3 * I_B + I_O;
    for (int it = gw; it < NIT; it += NGW) {
        int r = it;
        if (r < 4 * I_FF) {
            const int which = r / I_FF; r -= which * I_FF; const int f = which & 1, is3 = which >> 1;
            const int kb = r / 88, nb = r % 88, sc0 = nb * 32;
            const float* W = (is3 ? KP(w_ff3) : KP(w_ff1)) + ((size_t)(l * 2 + f)) * 1024 * 2816;
            bf16_t* WT = (bf16_t*)(ws + WS_W13 + f * SZ_W13);
            conv_item(W, 2816, sc0, WT, 1024, 256 * (sc0 / 128) + is3 * 128 + (sc0 % 128), kb * 64, scr, lane); continue; }
        r -= 4 * I_FF;
        if (r < 2 * I_F2) { const int f = r / I_F2; r -= f * I_F2; const int kb = r / 32, nb = r % 32;
            const float* W = KP(w_ff2) + ((size_t)(l * 2 + f)) * 2816 * 1024;
            conv_item(W, 1024, nb * 32, (bf16_t*)(ws + WS_W2 + f * SZ_W2), 2816, nb * 32, kb * 64, scr, lane); continue; }
        r -= 2 * I_F2;
        if (r < I_INA) { const int kb = r / 48, nb = r % 48;
            conv_item(KP(w_in) + (size_t)l * 1024 * 4640, 4640, nb * 32, (bf16_t*)(ws + WS_WIN), 1024, nb * 32, kb * 64, scr, lane); continue; }
        r -= I_INA;
        if (r < I_INB) { const int kb = r / 96, nb = r % 96; const int blk = nb / 16, within = (nb % 16) * 32;
            const int dstb = (blk == 0) ? 0 : (blk == 1) ? 1024 : (blk == 2) ? 1536 : (blk == 3) ? 512 : (blk == 4) ? 2048 : 2560;
            conv_item(KP(w_in) + (size_t)l * 1024 * 4640, 4640, 1568 + blk * 512 + within, (bf16_t*)(ws + WS_WIN), 1024, 2048 + dstb + within, kb * 64, scr, lane); continue; }
        r -= I_INB;
        if (r < 4 * I_G) { const int k = r / I_G; r -= k * I_G; const int kb = r / 32, nb = r % 32;
            conv_item(KP(w_gate) + ((size_t)(l * 4 + k)) * 1024 * 1024, 1024, nb * 32, (bf16_t*)(ws + WS_WG), 1024, k * 1024 + nb * 32, kb * 64, scr, lane); continue; }
        r -= 4 * I_G;
        if (r < 3 * I_B) { const int wb = r / I_B; r -= wb * I_B; const int kb = r / 32, nb = r % 32; const int k = (wb == 2) ? 3 : wb;
            conv_item(KP(w_branch) + ((size_t)(l * 4 + k)) * 512 * 1024, 1024, nb * 32, (bf16_t*)(ws + WS_WB + (size_t)wb * 1048576), 512, nb * 32, kb * 64, scr, lane); continue; }
        r -= 3 * I_B;
        { const int kb = r / 32, nb = r % 32;
            conv_item(KP(w_out) + (size_t)l * 1024 * 1024, 1024, nb * 32, (bf16_t*)(ws + WS_WO), 1024, nb * 32, kb * 64, scr, lane); }
    }
    __syncthreads();
    LAS float* ctab = (LAS float*)lds; LAS float* stab = ctab + 128;
    if (tid < 128) { float s, c; sincospif((float)tid * (1.f / 64.f), &s, &c); ctab[tid] = c; stab[tid] = s; }
    __syncthreads();
    const size_t gt = (size_t)bid_() * 512 + tid, NT = (size_t)gridDim.x * 512;
    {
        const float* win = KP(w_in) + (size_t)l * 1024 * 4640; const float* wa2 = KP(w_gla_a2) + (size_t)l * 2 * 16 * 256; bf16_t* WIN = (bf16_t*)(ws + WS_WIN);
        for (size_t idx = gt; idx < (size_t)2 * 256 * 1024; idx += NT) {
            const int dir = (int)(idx >> 18), n = (int)(idx >> 10) & 255, k = (int)idx & 1023;
            const f32x4* a = (const f32x4*)(win + (size_t)k * 4640 + 1536 + dir * 16);
            const float* w = wa2 + (size_t)dir * 16 * 256 + n;
            float s = 0.f;
#pragma unroll
            for (int q = 0; q < 4; ++q) { const f32x4 av = a[q]; s += av[0] * w[(4 * q + 0) * 256] + av[1] * w[(4 * q + 1) * 256] + av[2] * w[(4 * q + 2) * 256] + av[3] * w[(4 * q + 3) * 256]; }
            WIN[(size_t)(1536 + dir * 256 + n) * 1024 + k] = (bf16_t)f2bf(s);
        }
    }
    {
        const float* wb = KP(w_branch) + ((size_t)(l * 4 + 2)) * 512 * 1024; bf16_t* WB2 = (bf16_t*)(ws + WS_WB + (size_t)3 * 1048576);
        const float s128 = 0.08838834764831845f;
        for (size_t idx = gt; idx < (size_t)65536; idx += NT) {
            const int n = (int)idx & 1023, g = (int)(idx >> 10) & 3, q = (int)(idx >> 12);
            const float* col = wb + (size_t)(g * 128) * 1024 + n;
            float ac[8], as[8];
#pragma unroll
            for (int r = 0; r < 8; ++r) { ac[r] = 0.f; as[r] = 0.f; }
#pragma unroll 8
            for (int k2 = 0; k2 < 128; ++k2) { const float w = col[(size_t)k2 * 1024];
#pragma unroll
                for (int r = 0; r < 8; ++r) { const int m = (k2 * (8 * q + r)) & 127; ac[r] += ctab[m] * w; as[r] += stab[m] * w; } }
            u32x4 oc, os;
            oc.x = pk2(ac[0] * s128, ac[1] * s128); oc.y = pk2(ac[2] * s128, ac[3] * s128); oc.z = pk2(ac[4] * s128, ac[5] * s128); oc.w = pk2(ac[6] * s128, ac[7] * s128);
            os.x = pk2(-as[0] * s128, -as[1] * s128); os.y = pk2(-as[2] * s128, -as[3] * s128); os.z = pk2(-as[4] * s128, -as[5] * s128); os.w = pk2(-as[6] * s128, -as[7] * s128);
            bf16_t* o = WB2 + (size_t)n * 1024 + g * 128 + 8 * q;
            *(u32x4*)o = oc; *(u32x4*)(o + 512) = os;
        }
    }
    __syncthreads();
}

__device__ __forceinline__ void mods_phase(LAS unsigned char* lds) {
    const int tid = tid_(), lane = tid & 63, wave = tid >> 6;
    if (bid_() >= 72) return;
    LAS float* sc = (LAS float*)lds; LAS float* red = sc + 3072;
    for (int i = tid; i < 3072; i += 512) { const int v = i >> 10, k = i & 1023; const float x = (v < 2) ? KP(c)[v * 1024 + k] : KP(c_ctx)[k]; sc[i] = x / (1.f + __expf(-x)); }
    __syncthreads();
    for (int it = bid_(); it < 72; it += gridDim.x) {
        const int l = it / 36, cb = it % 36;
        const float* W = KP(w_ada) + (size_t)l * 1024 * 9216 + cb * 256 + 4 * lane;
        f32x4 a0 = {0.f, 0.f, 0.f, 0.f}, a1 = a0, a2 = a0;
#pragma unroll 8
        for (int i = 0; i < 128; ++i) { const int k = wave + 8 * i; const f32x4 w = *(const f32x4*)(W + (size_t)k * 9216);
            a0 = a0 + w * sc[k]; a1 = a1 + w * sc[1024 + k]; a2 = a2 + w * sc[2048 + k]; }
        *(LAS f32x4*)(red + (wave * 3 + 0) * 256 + 4 * lane) = a0; *(LAS f32x4*)(red + (wave * 3 + 1) * 256 + 4 * lane) = a1; *(LAS f32x4*)(red + (wave * 3 + 2) * 256 + 4 * lane) = a2;
        __syncthreads();
        float* MOD = (float*)(KP(ws) + WS_MOD);
        for (int o = tid; o < 768; o += 512) { const int v = o >> 8, cc = o & 255; float s = KP(b_ada)[(size_t)l * 9216 + cb * 256 + cc];
#pragma unroll
            for (int w = 0; w < 8; ++w) s += red[(w * 3 + v) * 256 + cc];
            MOD[(size_t)(l * 3 + v) * 9216 + cb * 256 + cc] = s; }
        __syncthreads();
    }
}

__device__ __forceinline__ void norm_load_row(f32x4 (&v)[4], int row, const float* src_lat, const float* src_ctx, const float* parts, int nparts, int lane) {
    const float* xr = (row < ML) ? src_lat + (size_t)row * 1024 : src_ctx + (size_t)(row - ML) * 1024;
#pragma unroll
    for (int j = 0; j < 4; ++j) v[j] = *(const f32x4*)(xr + 4 * lane + 256 * j);
    if (row >= ML && nparts) {
#pragma unroll
        for (int s2 = 0; s2 < 4; ++s2)
#pragma unroll
            for (int j = 0; j < 4; ++j) v[j] = v[j] + *(const f32x4*)(parts + (size_t)s2 * 524288 + (size_t)(row - ML) * 1024 + 4 * lane + 256 * j);
    }
}
__device__ __forceinline__ void norm_finish_row(const f32x4 (&v)[4], int row, const float* g, const float* modl, int jshift, int jscale, bf16_t* H, float* xc, int lane) {
    const int mid = row < 8192 ? 0 : (row < ML ? 1 : 2);
    const float* sh = modl + (size_t)(mid * 9 + jshift) * 1024; const float* scp = modl + (size_t)(mid * 9 + jscale) * 1024;
    float ss = 0.f;
#pragma unroll
    for (int j = 0; j < 4; ++j) ss += v[j][0] * v[j][0] + v[j][1] * v[j][1] + v[j][2] * v[j][2] + v[j][3] * v[j][3];
    const float rinv = rsqrtf(wave_sum(ss) * (1.f / 1024.f) + EPS);
#pragma unroll
    for (int j = 0; j < 4; ++j) { const int col = 4 * lane + 256 * j;
        const f32x4 gv = *(const f32x4*)(g + col), shv = *(const f32x4*)(sh + col), scv = *(const f32x4*)(scp + col);
        f32x4 y = v[j] * rinv * gv; y = y * (scv + 1.f) + shv;
        u32x2 o; o.x = pk2(y[0], y[1]); o.y = pk2(y[2], y[3]);
        *(u32x2*)(H + (size_t)row * 1024 + col) = o;
        if (row >= ML) *(f32x4*)(xc + (size_t)(row - ML) * 1024 + col) = v[j]; }
}
__device__ __forceinline__ void norm_phase(const float* src_lat, const float* src_ctx, const float* g, const float* modl, int jshift, int jscale, bf16_t* H, int nrows, const float* parts, int nparts, float* xc) {
    const int lane = tid_() & 63, wave = tid_() >> 6;
    const int gw = bid_() * 8 + wave, NGW = gridDim.x * 8;
    for (int row = gw; row < nrows; row += 2 * NGW) {
        const int r1 = row + NGW; const bool has1 = r1 < nrows;
        f32x4 va[4], vb[4];
        norm_load_row(va, row, src_lat, src_ctx, parts, nparts, lane);
        if (has1) norm_load_row(vb, r1, src_lat, src_ctx, parts, nparts, lane);
        else {
#pragma unroll
            for (int j = 0; j < 4; ++j) vb[j] = (f32x4){0.f, 0.f, 0.f, 0.f}; }
        norm_finish_row(va, row, g, modl, jshift, jscale, H, xc, lane);
        if (has1) norm_finish_row(vb, r1, g, modl, jshift, jscale, H, xc, lane);
    }
}
__device__ __forceinline__ void final_norm(float* out, const float* g) {
    const int lane = tid_() & 63, wave = tid_() >> 6;
    const int gw = bid_() * 8 + wave, NGW = gridDim.x * 8;
    for (int row = gw; row < ML; row += 2 * NGW) {
        const int r1 = (row + NGW < ML) ? row + NGW : row;
        float* xa = out + (size_t)row * 1024; float* xb = out + (size_t)r1 * 1024;
        f32x4 va[4], vb[4]; float sa = 0.f, sb = 0.f;
#pragma unroll
        for (int j = 0; j < 4; ++j) { va[j] = *(const f32x4*)(xa + 4 * lane + 256 * j); vb[j] = *(const f32x4*)(xb + 4 * lane + 256 * j); }
#pragma unroll
        for (int j = 0; j < 4; ++j) { sa += va[j][0] * va[j][0] + va[j][1] * va[j][1] + va[j][2] * va[j][2] + va[j][3] * va[j][3]; sb += vb[j][0] * vb[j][0] + vb[j][1] * vb[j][1] + vb[j][2] * vb[j][2] + vb[j][3] * vb[j][3]; }
        const float ra = rsqrtf(wave_sum(sa) * (1.f / 1024.f) + EPS), rb = rsqrtf(wave_sum(sb) * (1.f / 1024.f) + EPS);
#pragma unroll
        for (int j = 0; j < 4; ++j) { const int col = 4 * lane + 256 * j; const f32x4 gv = *(const f32x4*)(g + col);
            *(f32x4*)(xa + col) = va[j] * ra * gv; if (r1 != row) *(f32x4*)(xb + col) = vb[j] * rb * gv; }
    }
}

__device__ __forceinline__ int chunk_row0(int b, int c) { return (c < 4) ? (ML + b * 256 + c * 64) : (b * 8192 + (c - 4) * 64); }

__device__ __forceinline__ void gla_cumsum(LAS float* gs, const bf16_t* PA, int row0, int h, int tid) {
    {
        bf16_t t[16];
#pragma unroll
        for (int u = 0; u < 16; ++u) { const int idx = tid + 512 * u; const int dir = idx >> 12, pp = (idx >> 6) & 63, d = idx & 63;
            t[u] = PA[(size_t)(row0 + pp) * LDPA + 1536 + dir * 256 + h * 64 + d]; }
#pragma unroll
        for (int u = 0; u < 16; ++u) gs[tid + 512 * u] = bf2f(t[u]);
    }
    __syncthreads();
    {
        const int col = tid & 127, seg = tid >> 7, dir = col >> 6, d = col & 63;
        LAS float* segsum = gs + 8192;
        LAS float* g0 = gs + dir * 4096 + d;
        float s = 0.f;
        if (dir == 0) { for (int q = 0; q < 16; ++q) { const int pp = 16 * seg + q; s += g0[pp * 64]; g0[pp * 64] = s; } }
        else { for (int q = 15; q >= 0; --q) { const int pp = 16 * seg + q; s += g0[pp * 64]; g0[pp * 64] = s; } }
        segsum[seg * 128 + col] = s;
        __syncthreads();
        float off = 0.f;
        if (dir == 0) { for (int t = 0; t < seg; ++t) off += segsum[t * 128 + col]; }
        else { for (int t = 3; t > seg; --t) off += segsum[t * 128 + col]; }
        for (int q = 0; q < 16; ++q) { const int pp = 16 * seg + q; g0[pp * 64] += off; }
    }
    __syncthreads();
}

__device__ __forceinline__ void gla1_item(LAS unsigned char* lds, int item) {
    const int tid = tid_(), lane = tid & 63, wave = tid >> 6;
    const int c = item % 132, h = (item / 132) & 3, b = item / 528;
    const int row0 = chunk_row0(b, c);
    const bf16_t* PA = (const bf16_t*)(KP(ws) + WS_PA);
    LAS float* gs = (LAS float*)lds;
    LAS bf16_t* kdec = (LAS bf16_t*)(lds + 32768);
    LAS bf16_t* vt = (LAS bf16_t*)(lds + 32768 + 18432);
    gla_cumsum(gs, PA, row0, h, tid);
    {
        bf16_t tk[16], tv[16];
#pragma unroll
        for (int u = 0; u < 16; ++u) { const int idx = tid + 512 * u; const int pp = (idx >> 6) & 63, d = idx & 63;
            tk[u] = PA[(size_t)(row0 + pp) * LDPA + 256 + h * 64 + d];
            tv[u] = PA[(size_t)(row0 + (idx >> 7)) * LDPA + 512 + h * 128 + (idx & 127)]; }
#pragma unroll
        for (int u = 0; u < 16; ++u) { const int idx = tid + 512 * u; const int dir = idx >> 12, pp = (idx >> 6) & 63, d = idx & 63;
            const float be = dir ? gs[4096 + d] : gs[63 * 64 + d];
            kdec[(dir * 64 + d) * 72 + pp] = (bf16_t)f2bf(bf2f(tk[u]) * __expf(be - gs[idx]));
            vt[(idx & 127) * 72 + (idx >> 7)] = tv[u]; }
    }
    if (tid < 128) { const int dir = tid >> 6, d = tid & 63; const float be = dir ? gs[4096 + d] : gs[63 * 64 + d];
        ((float*)(KP(ws) + WS_DT))[((size_t)((dir * 8 + b * 4 + h) * 132 + c)) * 64 + d] = __expf(be); }
    __syncthreads();
    {
        const int dir = wave >> 2, mt = wave & 3;
        bf16_t* slot = (bf16_t*)(KP(ws) + WS_S) + ((size_t)((dir * 8 + b * 4 + h) * 132 + c)) * 8192;
        const LAS bf16_t* ka = kdec + dir * 64 * 72;
#pragma unroll
        for (int nt = 0; nt < 8; ++nt) {
            f32x4 acc = {0.f, 0.f, 0.f, 0.f};
#pragma unroll
            for (int ks = 0; ks < 2; ++ks) {
                const bf16x8 a = lfrag(ka, mt * 16 + (lane & 15), 72, ks * 32 + (lane >> 4) * 8);
                const bf16x8 bb = lfrag(vt, nt * 16 + (lane & 15), 72, ks * 32 + (lane >> 4) * 8);
                acc = __builtin_amdgcn_mfma_f32_16x16x32_bf16(a, bb, acc, 0, 0, 0);
            }
            const int dk0 = mt * 16 + (lane >> 4) * 4, dv = nt * 16 + (lane & 15);
            u32x2 o; o.x = pk2(acc[0], acc[1]); o.y = pk2(acc[2], acc[3]);
            *(u32x2*)(slot + dv * 64 + dk0) = o;
        }
    }
    __syncthreads();
}

__device__ __forceinline__ void gla_scan() {
    unsigned* S32 = (unsigned*)(KP(ws) + WS_S); const float* DT = (const float*)(KP(ws) + WS_DT);
    const int gt = bid_() * 512 + tid_(), NT = gridDim.x * 512;
    for (int w = gt; w < 65536; w += NT) {
        const int chain = w >> 12, e2 = w & 4095, dir = chain >> 3;
        const int dk = (2 * e2) & 63;
        float s0 = 0.f, s1 = 0.f;
        for (int st = 0; st < 132; st += 12) {
            unsigned kd[12]; f32x2 dd[12]; size_t off[12];
#pragma unroll
            for (int q = 0; q < 12; ++q) { const int stq = st + q; const int c = dir ? (stq < 4 ? 3 - stq : 135 - stq) : stq;
                off[q] = ((size_t)(chain * 132 + c)) * 4096 + e2; kd[q] = S32[off[q]]; dd[q] = *(const f32x2*)(DT + ((size_t)(chain * 132 + c)) * 64 + dk); }
#pragma unroll
            for (int q = 0; q < 12; ++q) { S32[off[q]] = pk2(s0, s1); s0 = dd[q][0] * s0 + bflo(kd[q]); s1 = dd[q][1] * s1 + bfhi(kd[q]); }
        }
    }
}

__device__ __forceinline__ void gla3_item(int l, LAS unsigned char* lds, int item) {
    const int tid = tid_(), lane = tid & 63, wave = tid >> 6;
    const int c = item % 132, h = (item / 132) & 3, b = item / 528;
    const int row0 = chunk_row0(b, c);
    const bf16_t* PA = (const bf16_t*)(KP(ws) + WS_PA); bf16_t* PB = (bf16_t*)(KP(ws) + WS_PB);
    LAS float* gs = (LAS float*)lds;
    LAS bf16_t* af = (LAS bf16_t*)lds;
    LAS bf16_t* qd = (LAS bf16_t*)(lds + 32768);
    LAS bf16_t* kd = (LAS bf16_t*)(lds + 51200);
    LAS bf16_t* Sd = (LAS bf16_t*)(lds + 69632);
    LAS bf16_t* vt = (LAS bf16_t*)(lds + 106496);
    LAS float* ssq = (LAS float*)(lds + 124928);
    gla_cumsum(gs, PA, row0, h, tid);
    {
        bf16_t tq[8], tk[8], tv[16]; u32x4 ts[4];
#pragma unroll
        for (int u = 0; u < 8; ++u) { const int idx = tid + 512 * u; const int pp = idx >> 6, d = idx & 63;
            tq[u] = PA[(size_t)(row0 + pp) * LDPA + h * 64 + d]; tk[u] = PA[(size_t)(row0 + pp) * LDPA + 256 + h * 64 + d]; }
#pragma unroll
        for (int u = 0; u < 16; ++u) { const int idx = tid + 512 * u; tv[u] = PA[(size_t)(row0 + (idx >> 7)) * LDPA + 512 + h * 128 + (idx & 127)]; }
#pragma unroll
        for (int u = 0; u < 4; ++u) { const int idx = tid + 512 * u; const int dir = idx >> 10, dv = (idx >> 3) & 127, part = idx & 7;
            const bf16_t* slot = (const bf16_t*)(KP(ws) + WS_S) + ((size_t)((dir * 8 + b * 4 + h) * 132 + c)) * 8192;
            ts[u] = *(const u32x4*)(slot + dv * 64 + part * 8); }
#pragma unroll
        for (int u = 0; u < 8; ++u) { const int idx = tid + 512 * u; const int pp = idx >> 6, d = idx & 63;
            const float q = bf2f(tq[u]), k = bf2f(tk[u]);
            const float bf = gs[idx], bb = gs[4096 + idx];
            qd[pp * 72 + d] = (bf16_t)f2bf(q * __expf(bf)); kd[pp * 72 + d] = (bf16_t)f2bf(k * __expf(-bf));
            qd[(64 + pp) * 72 + d] = (bf16_t)f2bf(q * __expf(bb)); kd[(64 + pp) * 72 + d] = (bf16_t)f2bf(k * __expf(-bb)); }
#pragma unroll
        for (int u = 0; u < 16; ++u) { const int idx = tid + 512 * u; vt[(idx & 127) * 72 + (idx >> 7)] = tv[u]; }
#pragma unroll
        for (int u = 0; u < 4; ++u) { const int idx = tid + 512 * u; const int dir = idx >> 10, dv = (idx >> 3) & 127, part = idx & 7;
            *(LAS u32x4*)(Sd + (dir * 128 + dv) * 72 + part * 8) = ts[u]; }
    }
    __syncthreads();
    {
        const int dir = wave >> 2, mt = wave & 3; const int i = mt * 16 + (lane & 15);
#pragma unroll
        for (int nt = 0; nt < 4; ++nt) {
            f32x4 acc = {0.f, 0.f, 0.f, 0.f};
#pragma unroll
            for (int ks = 0; ks < 2; ++ks) {
                const bf16x8 kf = lfrag(kd + dir * 64 * 72, nt * 16 + (lane & 15), 72, ks * 32 + (lane >> 4) * 8);
                const bf16x8 qf = lfrag(qd + dir * 64 * 72, i, 72, ks * 32 + (lane >> 4) * 8);
                acc = __builtin_amdgcn_mfma_f32_16x16x32_bf16(kf, qf, acc, 0, 0, 0);
            }
            const int j0 = nt * 16 + (lane >> 4) * 4;
#pragma unroll
            for (int jj = 0; jj < 4; ++jj) { const int j = j0 + jj; const bool keep = dir ? (j >= i) : (j <= i); acc[jj] = keep ? acc[jj] : 0.f; }
            u32x2 o; o.x = pk2(acc[0], acc[1]); o.y = pk2(acc[2], acc[3]);
            *(LAS u32x2*)(af + (dir * 64 + i) * 72 + j0) = o;
        }
    }
    __syncthreads();
    {
        const int mt = wave >> 1, nt0 = 4 * (wave & 1); const int i = mt * 16 + (lane & 15);
        f32x4 acc[4];
#pragma unroll
        for (int nt = 0; nt < 4; ++nt) acc[nt] = (f32x4){0.f, 0.f, 0.f, 0.f};
#pragma unroll
        for (int seg = 0; seg < 4; ++seg) {
            const int dir = seg >> 1;
            const LAS bf16_t* Aop = (seg & 1) ? (af + dir * 64 * 72) : (qd + dir * 64 * 72);
            const LAS bf16_t* Bop = (seg & 1) ? vt : (Sd + dir * 128 * 72);
#pragma unroll
            for (int ks = 0; ks < 2; ++ks) {
                const bf16x8 a = lfrag(Aop, i, 72, ks * 32 + (lane >> 4) * 8);
#pragma unroll
                for (int nt = 0; nt < 4; ++nt) {
                    const bf16x8 bb = lfrag(Bop, (nt0 + nt) * 16 + (lane & 15), 72, ks * 32 + (lane >> 4) * 8);
                    acc[nt] = __builtin_amdgcn_mfma_f32_16x16x32_bf16(bb, a, acc[nt], 0, 0, 0);
                }
            }
        }
        float ss = 0.f;
#pragma unroll
        for (int nt = 0; nt < 4; ++nt) ss += acc[nt][0] * acc[nt][0] + acc[nt][1] * acc[nt][1] + acc[nt][2] * acc[nt][2] + acc[nt][3] * acc[nt][3];
        ss += __shfl_xor(ss, 16); ss += __shfl_xor(ss, 32);
        if (lane < 16) ssq[(wave & 1) * 64 + i] = ss;
        __syncthreads();
        const float rinv = rsqrtf((ssq[i] + ssq[64 + i]) * (1.f / 128.f) + EPS);
        const float* go = KP(g_gla_norm) + (size_t)(l * 4 + h) * 128;
        u32x2 rr[4]; f32x4 gvv[4];
#pragma unroll
        for (int nt = 0; nt < 4; ++nt) { const int dv0 = (nt0 + nt) * 16 + (lane >> 4) * 4; gvv[nt] = *(const f32x4*)(go + dv0); rr[nt] = *(const u32x2*)(PA + (size_t)(row0 + i) * LDPA + 1024 + h * 128 + dv0); }
#pragma unroll
        for (int nt = 0; nt < 4; ++nt) {
            const int dv0 = (nt0 + nt) * 16 + (lane >> 4) * 4;
            const f32x4 gv = gvv[nt];
            const u32x2 r = rr[nt];
            const float o0 = acc[nt][0] * rinv * gv[0] * siluf_(bflo(r.x)), o1 = acc[nt][1] * rinv * gv[1] * siluf_(bfhi(r.x));
            const float o2 = acc[nt][2] * rinv * gv[2] * siluf_(bflo(r.y)), o3 = acc[nt][3] * rinv * gv[3] * siluf_(bfhi(r.y));
            u32x2 o; o.x = pk2(o0, o1); o.y = pk2(o2, o3);
            *(u32x2*)(PB + (size_t)(row0 + i) * LDPB + 2048 + h * 128 + dv0) = o;
        }
    }
    __syncthreads();
}

__device__ __forceinline__ void sgu_item(int l, LAS unsigned char* lds, int item) {
    const int tid = tid_(), lane = tid & 63, wave = tid >> 6;
    const int g = item & 3, ci = item >> 2; const int row0 = ci * 128;
    bf16_t* PB = (bf16_t*)(KP(ws) + WS_PB);
    LAS bf16_t* zt = (LAS bf16_t*)lds;
    LAS bf16_t* wl = (LAS bf16_t*)(lds + 34816);
    unsigned tv16[16];
#pragma unroll
    for (int jr = 0; jr < 16; ++jr) tv16[jr] = *(const unsigned*)(PB + (size_t)(row0 + wave * 16 + jr) * LDPB + 1024 + g * 128 + 2 * lane);
#pragma unroll
    for (int jr = 0; jr < 16; ++jr) { const int j = wave * 16 + jr;
        const unsigned v = tv16[jr];
        const float x0 = bflo(v), x1 = bfhi(v);
        const float mean = wave_sum(x0 + x1) * (1.f / 128.f);
        const float d0 = x0 - mean, d1 = x1 - mean;
        const float rstd = rsqrtf(wave_sum(d0 * d0 + d1 * d1) * (1.f / 128.f) + EPS);
        zt[(2 * lane) * 136 + j] = (bf16_t)f2bf(d0 * rstd); zt[(2 * lane + 1) * 136 + j] = (bf16_t)f2bf(d1 * rstd); }
    const float* W = KP(w_sgu) + (size_t)(l * 4 + g) * 128 * 128;
    {
        f32x4 tw8[8];
#pragma unroll
        for (int u = 0; u < 8; ++u) { const int idx = tid + 512 * u; tw8[u] = *(const f32x4*)(W + (idx >> 5) * 128 + (idx & 31) * 4); }
#pragma unroll
        for (int u = 0; u < 8; ++u) { const int idx = tid + 512 * u; const int i = idx >> 5, j4 = (idx & 31) * 4;
            u32x2 o; o.x = pk2(tw8[u][0], tw8[u][1]); o.y = pk2(tw8[u][2], tw8[u][3]); *(LAS u32x2*)(wl + i * 136 + j4) = o; }
    }
    __syncthreads();
    {
        const int i = wave * 16 + (lane & 15);
        f32x4 acc[8];
#pragma unroll
        for (int nt = 0; nt < 8; ++nt) acc[nt] = (f32x4){0.f, 0.f, 0.f, 0.f};
#pragma unroll
        for (int ks = 0; ks < 4; ++ks) {
            const bf16x8 a = lfrag(wl, i, 136, ks * 32 + (lane >> 4) * 8);
#pragma unroll
            for (int nt = 0; nt < 8; ++nt) {
                const bf16x8 bb = lfrag(zt, nt * 16 + (lane & 15), 136, ks * 32 + (lane >> 4) * 8);
                acc[nt] = __builtin_amdgcn_mfma_f32_16x16x32_bf16(bb, a, acc[nt], 0, 0, 0);
            }
        }
        const float bias = KP(b_sgu)[(size_t)(l * 4 + g) * 128 + i];
        u32x2 uu[8];
#pragma unroll
        for (int nt = 0; nt < 8; ++nt) uu[nt] = *(const u32x2*)(PB + (size_t)(row0 + i) * LDPB + g * 128 + nt * 16 + (lane >> 4) * 4);
#pragma unroll
        for (int nt = 0; nt < 8; ++nt) {
            const int c0 = nt * 16 + (lane >> 4) * 4;
            bf16_t* up = PB + (size_t)(row0 + i) * LDPB + g * 128 + c0;
            const u32x2 u = uu[nt];
            u32x2 o; o.x = pk2(bflo(u.x) * (acc[nt][0] + bias), bfhi(u.x) * (acc[nt][1] + bias)); o.y = pk2(bflo(u.y) * (acc[nt][2] + bias), bfhi(u.y) * (acc[nt][3] + bias));
            *(u32x2*)up = o;
        }
    }
    __syncthreads();
}

__device__ __forceinline__ void fft_item(LAS unsigned char* lds, int seg, int logN, int pair) {
    const int tid = tid_();
    const float* TW = (const float*)(KP(ws) + WS_TW);
    LAS float* re = (LAS float*)lds; LAS float* im = re + 8192; LAS float* tw = re + 16384;
    const int N = 1 << logN;
    unsigned* fc = (seg < 2) ? (unsigned*)(KP(ws) + WS_FT) + ((size_t)(seg * 256 + pair)) * 8192 : (unsigned*)(KP(ws) + WS_FTC) + ((size_t)((seg - 2) * 256 + pair)) * 256;
    unsigned* fs = (seg < 2) ? (unsigned*)(KP(ws) + WS_FOS) + ((size_t)(seg * 256 + pair)) * 8192 : (unsigned*)(KP(ws) + WS_FOSC) + ((size_t)((seg - 2) * 256 + pair)) * 256;
    {
        f32x4 tt[8];
#pragma unroll
        for (int u = 0; u < 8; ++u) { const int i = tid + 512 * u; tt[u] = (i < (N >> 1)) ? *(const f32x4*)(TW + 4 * i) : (f32x4){0.f, 0.f, 0.f, 0.f}; }
#pragma unroll
        for (int u = 0; u < 8; ++u) { const int i = tid + 512 * u; if (i < (N >> 1)) *(LAS f32x4*)(tw + 4 * i) = tt[u]; }
    }
    {
        unsigned vv[16];
#pragma unroll
        for (int u = 0; u < 16; ++u) { const int n = tid + 512 * u; vv[u] = (n < N) ? fc[n] : 0u; }
#pragma unroll
        for (int u = 0; u < 16; ++u) { const int n = tid + 512 * u;
            if (n < N) { const int r = (int)(__brev((unsigned)n) >> (32 - logN)); re[r] = bflo(vv[u]); im[r] = bfhi(vv[u]); } }
    }
    __syncthreads();
    for (int s = 1; s <= logN; ++s) {
        const int half = 1 << (s - 1);
        for (int j = tid; j < (N >> 1); j += 512) {
            const int pos = j & (half - 1); const int i0 = ((j >> (s - 1)) << s) + pos, i1 = i0 + half;
            const f32x2 w = *(const LAS f32x2*)(tw + 2 * (half - 1 + pos));
            const float xr = re[i1], xi = im[i1]; const float tr = w[0] * xr - w[1] * xi, ti = w[0] * xi + w[1] * xr;
            const float ur = re[i0], ui = im[i0];
            re[i1] = ur - tr; im[i1] = ui - ti; re[i0] = ur + tr; im[i0] = ui + ti;
        }
        __syncthreads();
    }
    const float sc = 0.5f * rsqrtf((float)N);
    for (int k = tid; k < N; k += 512) {
        const int k2 = (N - k) & (N - 1);
        const float zr = re[k], zi = im[k], yr = re[k2], yi = im[k2];
        fc[k] = pk2((zr + yr) * sc, (zi + yi) * sc);
        fs[k] = pk2((yi - zi) * sc, (zr - yr) * sc);
    }
    __syncthreads();
}
__device__ __forceinline__ void fft_transpose_items(LAS unsigned char* lds, bool with_ctx) {
    const int tid = tid_(), lane = tid & 63, wave = tid >> 6;
    LAS unsigned* scr = (LAS unsigned*)(lds + wave * 16384);
    const int gw = bid_() * 8 + wave, NGW = gridDim.x * 8;
    unsigned* FN = (unsigned*)(KP(ws) + WS_FN);
    const int nlat = 2 * 8 * 128 * 2, nctx = with_ctx ? 2 * 8 * 4 * 2 : 0;
    for (int it = gw; it < nlat + nctx; it += NGW) {
        int r = it; const bool lat = r < nlat; if (!lat) r -= nlat;
        const int cs = r & 1; r >>= 1;
        const int ntb = lat ? 128 : 4; const int tb = r % ntb; r /= ntb; const int pb = r & 7, b = r >> 3;
        const size_t Nseg = lat ? 8192 : 256;
        const unsigned* src = (const unsigned*)(KP(ws) + (lat ? (cs ? WS_FOS : WS_FT) : (cs ? WS_FOSC : WS_FTC))) + ((size_t)(b * 256 + pb * 32)) * Nseg + tb * 64 + lane;
        unsigned t[32];
#pragma unroll
        for (int i = 0; i < 32; ++i) t[i] = src[(size_t)i * Nseg];
#pragma unroll
        for (int i = 0; i < 32; ++i) scr[i * 65 + lane] = t[i];
        asm volatile("s_waitcnt lgkmcnt(0)" ::: "memory");
        const int row0 = (lat ? b * 8192 : ML + b * 256) + tb * 64;
        unsigned* dst = FN + (size_t)row0 * 512 + cs * 256 + pb * 32 + (lane & 31);
#pragma unroll
        for (int i = 0; i < 32; ++i) { const int tk = 2 * i + (lane >> 5); dst[(size_t)tk * 512] = scr[(lane & 31) * 65 + tk]; }
        asm volatile("s_waitcnt lgkmcnt(0)" ::: "memory");
    }
}

__device__ __forceinline__ void conv3_item(int l, int item) {
    const int tid = tid_();
    bf16_t* PB = (bf16_t*)(KP(ws) + WS_PB);
    const float* w = KP(w_conv) + (size_t)l * 3 * 512;
    for (int e0 = tid; e0 < 16384; e0 += 2048) {
        unsigned c0[4], x0[4], cm[4], xm[4], cq[4], xq[4], cb[4];
#pragma unroll
        for (int u = 0; u < 4; ++u) {
            const int e = e0 + 512 * u; const int row = item * 64 + (e >> 8), cp = e & 255;
            const bool lat = row < ML; const int pos = lat ? (row & 63) : ((row - ML) & 255); const int lastp = lat ? 63 : 255;
            const bf16_t* base = PB + (size_t)row * LDPB + 2 * cp;
            c0[u] = *(const unsigned*)(base + 2048); x0[u] = *(const unsigned*)(base + 2560); cb[u] = *(const unsigned*)(base + 512);
            cm[u] = 0u; xm[u] = 0u; cq[u] = 0u; xq[u] = 0u;
            if (pos > 0) { cm[u] = *(const unsigned*)(base - LDPB + 2048); xm[u] = *(const unsigned*)(base - LDPB + 2560); }
            if (pos < lastp) { cq[u] = *(const unsigned*)(base + LDPB + 2048); xq[u] = *(const unsigned*)(base + LDPB + 2560); }
        }
#pragma unroll
        for (int u = 0; u < 4; ++u) {
            const int e = e0 + 512 * u; const int row = item * 64 + (e >> 8), cp = e & 255;
            bf16_t* base = PB + (size_t)row * LDPB + 2 * cp;
            const float zl0 = bflo(cm[u]) * bflo(xm[u]), zl1 = bfhi(cm[u]) * bfhi(xm[u]), zr0 = bflo(cq[u]) * bflo(xq[u]), zr1 = bfhi(cq[u]) * bfhi(xq[u]);
            const float z0 = bflo(c0[u]) * bflo(x0[u]), z1 = bfhi(c0[u]) * bfhi(x0[u]);
            const f32x2 w0 = *(const f32x2*)(w + 2 * cp), w1 = *(const f32x2*)(w + 512 + 2 * cp), w2 = *(const f32x2*)(w + 1024 + 2 * cp);
            const float y0 = zl0 * w0[0] + z0 * w1[0] + zr0 * w2[0], y1 = zl1 * w0[1] + z1 * w1[1] + zr1 * w2[1];
            *(unsigned*)(base + 512) = pk2(bflo(cb[u]) * y0, bfhi(cb[u]) * y1);
        }
    }
}


#define XB_TMO      128
#define XB_XCNT(j)  (256  + 64 * (j))
#define XB_XSUB(j)  (1280 + 64 * (j))
#define XB_XGEN(j)  (2304 + 64 * (j))
#define XB_TOP      3328
#define XB_TOPGEN   3392
#define XB_SPIN_CAP (1u << 20)
constexpr int LDS_BARST = LDS_BYTES - 16;
__device__ __forceinline__ unsigned xb_ld(unsigned* p)              { return __hip_atomic_load(p, __ATOMIC_RELAXED, __HIP_MEMORY_SCOPE_AGENT); }
__device__ __forceinline__ unsigned xb_add(unsigned* p, unsigned v) { return __hip_atomic_fetch_add(p, v, __ATOMIC_RELAXED, __HIP_MEMORY_SCOPE_AGENT); }
__device__ __forceinline__ unsigned xb_xcc_id() { return (unsigned)__builtin_amdgcn_s_getreg((3 << 11) | 20) & 0xFu; }
#define XB_SPIN(cond, bar) do { unsigned _sp = 0; while (cond) { __builtin_amdgcn_s_sleep(1); \
    if ((++_sp & 255u) == 0u) { if (xb_ld(&(bar)[XB_TMO])) break; if (_sp > XB_SPIN_CAP) { atomicAdd(&(bar)[XB_TMO], 1u); break; } } } } while (0)
__device__ __forceinline__ void xcd_barrier_complete(unsigned* bar, unsigned x, unsigned& nloc, unsigned& nx) {
    const unsigned G = gridDim.x;
    unsigned sum, cnt, mine, sp = 0u;
    for (;;) {
        sum = 0u; cnt = 0u; mine = 0u;
#pragma unroll
        for (unsigned j = 0; j < 16; ++j) { const unsigned c = xb_ld(&bar[XB_XCNT(j)]); sum += c; cnt += (c > 0u) ? 1u : 0u; mine = (j == x) ? c : mine; }
        if (sum == G) break;
        __builtin_amdgcn_s_sleep(1);
        if ((++sp & 255u) == 0u) { if (xb_ld(&bar[XB_TMO])) break; if (sp > XB_SPIN_CAP) { atomicAdd(&bar[XB_TMO], 1u); break; } }
    }
    nloc = mine > 0u ? mine : 1u; nx = cnt > 0u ? cnt : 1u;
}
__device__ __forceinline__ void xcd_barrier(LAS unsigned char* lds) {
    asm volatile("s_waitcnt vmcnt(0) lgkmcnt(0)" ::: "memory");
    __syncthreads();
    if (tid_() == 0) {
        unsigned* bar = (unsigned*)(KP(ws) + WS_BAR);
        volatile LAS unsigned* st = (volatile LAS unsigned*)(lds + LDS_BARST);
        const unsigned x = xb_xcc_id();
        unsigned nloc = st[0], nx = st[1];
        if (nloc == 0u) { xcd_barrier_complete(bar, x, nloc, nx); st[0] = nloc; st[1] = nx; }
        const unsigned old = xb_add(&bar[XB_XSUB(x)], 1u);
        const unsigned gen = old / nloc;
        if (old + 1u == (gen + 1u) * nloc) {
            __builtin_amdgcn_fence(__ATOMIC_RELEASE, "agent");
            asm volatile("s_waitcnt vmcnt(0)" ::: "memory");
            const unsigned og = xb_add(&bar[XB_TOP], 1u);
            const unsigned tg = og / nx;
            if (og + 1u == (tg + 1u) * nx) xb_add(&bar[XB_TOPGEN], 1u);
            else XB_SPIN(xb_ld(&bar[XB_TOPGEN]) == tg, bar);
            __builtin_amdgcn_fence(__ATOMIC_ACQUIRE, "agent");
            xb_add(&bar[XB_XGEN(x)], 1u);
            asm volatile("s_waitcnt vmcnt(0)" ::: "memory");
        } else {
            XB_SPIN(xb_ld(&bar[XB_XGEN(x)]) == gen, bar);
            __builtin_amdgcn_fence(__ATOMIC_ACQUIRE, "agent");
            asm volatile("s_waitcnt vmcnt(0)" ::: "memory");
        }
    }
    __syncthreads();
}

__global__ void __launch_bounds__(512, 2) fwd_megakernel(Params p_unused) {
    extern __shared__ __attribute__((aligned(16))) unsigned char lds_raw[];
    LAS unsigned char* lds = (LAS unsigned char*)lds_raw;
    cg::grid_group grid = cg::this_grid();
#define GRID_SYNC() xcd_barrier(lds)
    const int G = gridDim.x;
    if (tid_() < 4) ((LAS unsigned*)(lds + LDS_BARST))[tid_()] = 0u;
    __syncthreads();
    if (bid_() == 0) {
        unsigned* bw = (unsigned*)(KP(ws) + WS_BAR);
        for (int i = tid_(); i < 3456; i += 512) __hip_atomic_store(bw + i, 0u, __ATOMIC_RELAXED, __HIP_MEMORY_SCOPE_AGENT);
        asm volatile("s_waitcnt vmcnt(0)" ::: "memory"); __syncthreads();
    }
    grid.sync();
    if (tid_() == 0) (void)xb_add(&((unsigned*)(KP(ws) + WS_BAR))[XB_XCNT(xb_xcc_id())], 1u);

    mods_phase(lds);
    __syncthreads();
    { float* TW = (float*)(KP(ws) + WS_TW);
      for (int k = bid_() * 512 + tid_(); k < 8191; k += G * 512) {
          const int sI = 32 - __clz(k + 1), half = 1 << (sI - 1), pos = k + 1 - half; float s, c; sincospif((float)pos / (float)half, &s, &c); TW[2 * k] = c; TW[2 * k + 1] = -s; } }
    convert_layer(0, lds);
    GRID_SYNC();

#ifndef MIXSEL
#define MIXSEL 15
#endif
#ifndef NPH
#define NPH 26
#endif
    for (int ph = 0; ph < NPH; ++ph) {
        const int l = ph / 13, k = ph % 13;
        const bool first = (l == 0);
        const int nMfull = 66, nMlat = 64;
        unsigned char* ws = KP(ws);
        if (k == 0 || k == 3 || k == 10) {
            if (k == 0 && l == 1) convert_layer(1, lds);
            const int wn = (k == 0) ? 0 : (k == 3 ? 1 : 2);
            const float* sl = (k == 0 && first) ? KP(x) : KP(out); const float* scx = (k == 0 && first) ? KP(ctx) : (const float*)(ws + WS_XC);
            const int nrows = (k == 10 && !first) ? ML : MT;
            norm_phase(sl, scx, KP(g_norm) + (size_t)(l * 3 + wn) * 1024, (const float*)(ws + WS_MOD) + (size_t)l * 3 * 9216, 3 * wn, 3 * wn + 1, (bf16_t*)(ws + WS_H), nrows,
                       (const float*)(ws + WS_PART), (k == 0 && first) ? 0 : 4, (float*)(ws + WS_XC));
        } else if (k == 1 || k == 11) {
            const int f = (k == 11);
            SchedG S; S.init(WS_H, 2048, WS_W13 + f * SZ_W13, 2048, 1024, (f && !first) ? nMlat : nMfull, 22);
            EpiSwiGLU E{ws};
            gemm_phase(lds, ws, S, E);
        } else if (k == 2 || k == 12 || k == 9) {
            const bool op = (k == 9); const int f = (k == 12);
            SchedR S; EpiResid E;
            S.op = op ? 1 : 0; S.f = f; S.nctx = op ? (first ? 32 : 0) : ((f && !first) ? 0 : 32);
            E.ws = ws; E.l = l; E.which = op ? 5 : (f ? 8 : 2); E.coef = op ? 1.f : 0.5f; E.src_in = (k == 2 && first) ? 1 : 0;
            gemm_phase(lds, ws, S, E);
        } else if (k == 4) {
            SchedG S; S.init(WS_H, 2048, WS_WIN, 2048, 1024, nMfull, 20);
            EpiInproj E{ws, l};
            gemm_phase(lds, ws, S, E);
        } else if (k == 5) {
            const int nfftL = 512, ngla = 1056, nsgu = first ? 528 : 512, ncv = first ? 264 : 256, nfftS = first ? 512 : 0;
            const int total = nfftL + ngla + nsgu + ncv + nfftS;
            for (int it = bid_(); it < total; it += G) {
                int r = it;
                if (r < nfftL) { fft_item(lds, r >> 8, 13, r & 255); continue; } r -= nfftL;
                if (r < ngla) { gla1_item(lds, r); continue; } r -= ngla;
                if (r < nsgu) { sgu_item(l, lds, r); continue; } r -= nsgu;
                if (r < ncv) { conv3_item(l, r); continue; } r -= ncv;
                fft_item(lds, 2 + (r >> 8), 8, r & 255);
            }
        } else if (k == 6) {
            gla_scan();
            fft_transpose_items(lds, first);
        } else if (k == 7) {
            if (MIXSEL & 1) for (int it = bid_(); it < 1056; it += G) { if (!first && (it % 132) < 4) continue; gla3_item(l, lds, it); }
        } else if (k == 8) {
            SchedM S; S.nlat = 256; S.nctx = first ? 32 : 0; S.G = G; S.c = bid_();
            EpiMerge E{ws, l};
            gemm_phase(lds, ws, S, E);
        }
        GRID_SYNC();
    }
    final_norm(KP(out), KP(g_final));
}

extern "C" void kernel_launch(void* const* d_in, const int* in_sizes, int n_in, void* d_out, int out_size, void* d_ws, size_t ws_size, hipStream_t stream) {
    static int grid = 0;
    if (grid == 0) {
        if (ws_size < WS_END) { fprintf(stderr, "kernel_launch: workspace too small: %zu < %zu\n", ws_size, (size_t)WS_END); grid = -1; return; }
        int dev = 0, cus = 0, per_cu = 0;
        hipGetDevice(&dev);
        hipDeviceGetAttribute(&cus, hipDeviceAttributeMultiprocessorCount, dev);
        if (hipFuncSetAttribute((const void*)fwd_megakernel, hipFuncAttributeMaxDynamicSharedMemorySize, LDS_BYTES) != hipSuccess) { fprintf(stderr, "kernel_launch: hipFuncSetAttribute failed\n"); grid = -1; return; }
        if (hipOccupancyMaxActiveBlocksPerMultiprocessor(&per_cu, (const void*)fwd_megakernel, 512, LDS_BYTES) != hipSuccess || per_cu < 1) { fprintf(stderr, "kernel_launch: occupancy query gave %d\n", per_cu); per_cu = 1; }
        (void)hipGetLastError();
        grid = cus * per_cu;
    }
    if (grid < 0) return;
    Params p{};
    const float** pp = (const float**)&p;
    for (int i = 0; i < 22; ++i) pp[i] = (const float*)d_in[i];
    p.out = (float*)d_out; p.ws = (unsigned char*)d_ws;
    void* args[] = {&p};
    hipError_t e = hipLaunchCooperativeKernel((const void*)fwd_megakernel, dim3(grid), dim3(512), args, LDS_BYTES, stream);
    if (e != hipSuccess) fprintf(stderr, "cooperative launch failed: %s (grid %d)\n", hipGetErrorString(e), grid);
}
```
